# Optimizing an MI355X kernel written in HIP

```python
import jax, jax.numpy as jnp
from jax import lax
import numpy as np

D_MODEL = 2048
BATCH = 4
SEQ = 4096
DEPTH = 2

CHUNK = 64
QUERY_BLOCK = 128
D_MIX = D_MODEL
SB_WIDTH = D_MIX // 2
SB_HEADS = 8
SB_HEAD_DIM = SB_WIDTH // SB_HEADS
GLA_VALUE_WIDTH = D_MIX - SB_WIDTH
GLA_HEADS = 4
GLA_KEY_WIDTH = GLA_VALUE_WIDTH // 2
GLA_HEAD_K = GLA_KEY_WIDTH // GLA_HEADS
GLA_HEAD_V = GLA_VALUE_WIDTH // GLA_HEADS
GLA_GATE_RANK = 16
GLA_GATE_TAU = 16.0
NORM_EPS = 1e-6
SPLIT_SIZES = (SB_WIDTH, SB_WIDTH, SB_WIDTH, SB_WIDTH,
               GLA_KEY_WIDTH, GLA_KEY_WIDTH, GLA_VALUE_WIDTH,
               GLA_VALUE_WIDTH, GLA_GATE_RANK)
IN_WIDTH = sum(SPLIT_SIZES)

kernel_name = "hybrid_stickbreaking_gla_block"


def rms_norm(x, gain):
    xf = x.astype(jnp.float32)
    y = xf * lax.rsqrt(jnp.mean(xf * xf, axis=-1, keepdims=True) + NORM_EPS)
    return (y * gain.astype(jnp.float32)).astype(x.dtype)


def to_heads(t, n_heads):
    b, s, w = t.shape
    return t.reshape(b, s, n_heads, w // n_heads).transpose(0, 2, 1, 3)


def from_heads(t):
    b, h, s, d = t.shape
    return t.transpose(0, 2, 1, 3).reshape(b, s, h * d)


def stick_breaking_attention(q, k, v):
    _, _, s_len, d = q.shape
    scale = d ** -0.5
    outs = []
    for i in range(s_len // QUERY_BLOCK):
        start = i * QUERY_BLOCK
        end = start + QUERY_BLOCK
        qb = q[:, :, start:end].astype(jnp.float32)
        kb = k[:, :, :end].astype(jnp.float32)
        vb = v[:, :, :end].astype(jnp.float32)
        z = jnp.einsum('bhqd,bhkd->bhqk', qb, kb) * scale
        t_idx = start + jnp.arange(QUERY_BLOCK)[:, None]
        s_idx = jnp.arange(end)[None, :]
        mask = s_idx < t_idx
        log_fail = jnp.where(mask, jax.nn.log_sigmoid(-z), 0.0)
        later = lax.cumsum(log_fail, axis=3, reverse=True) - log_fail
        w = jnp.where(mask, jnp.exp(jax.nn.log_sigmoid(z) + later), 0.0)
        outs.append(jnp.einsum('bhqk,bhkd->bhqd', w, vb))
    return jnp.concatenate(outs, axis=2).astype(v.dtype)


def gated_linear_attention(q, k, v, log_alpha):
    b, h, s_len, dk = q.shape
    dv = v.shape[-1]
    n_c = s_len // CHUNK
    qf = (q.astype(jnp.float32) * dk ** -0.5).reshape(b, h, n_c, CHUNK, dk)
    kf = k.astype(jnp.float32).reshape(b, h, n_c, CHUNK, dk)
    vf = v.astype(jnp.float32).reshape(b, h, n_c, CHUNK, dv)
    cum = jnp.cumsum(log_alpha.astype(jnp.float32).reshape(b, h, n_c, CHUNK, dk), axis=3)
    q_dec = qf * jnp.exp(cum)
    k_inv = kf * jnp.exp(-cum)
    scores = jnp.einsum('bhncd,bhned->bhnce', q_dec, k_inv)
    causal = jnp.arange(CHUNK)[None, :] <= jnp.arange(CHUNK)[:, None]
    scores = jnp.where(causal, scores, 0.0)
    o_intra = jnp.einsum('bhnce,bhnev->bhncv', scores, vf)
    cum_last = cum[:, :, :, -1:, :]
    kv = jnp.einsum('bhncd,bhncv->bhndv', kf * jnp.exp(cum_last - cum), vf)
    chunk_decay = jnp.exp(cum_last[:, :, :, 0, :])

    def step(state, inp):
        dec, kv_c = inp
        return dec[..., None] * state + kv_c, state

    init = jnp.zeros((b, h, dk, dv), jnp.float32)
    _, states = lax.scan(step, init, (jnp.moveaxis(chunk_decay, 2, 0), jnp.moveaxis(kv, 2, 0)))
    states = jnp.moveaxis(states, 0, 2)
    o_inter = jnp.einsum('bhncd,bhndv->bhncv', q_dec, states)
    return (o_intra + o_inter).reshape(b, h, s_len, dv).astype(v.dtype)


def setup_inputs(seed: int = 0) -> dict:
    key = jax.random.key(seed)
    ks = jax.random.split(key, 11)
    f32 = jnp.float32
    x = jax.random.normal(ks[0], (BATCH, SEQ, D_MODEL), f32)
    norm_gain = 1.0 + 0.02 * jax.random.normal(ks[1], (DEPTH, D_MODEL), f32)
    w_in = jax.random.normal(ks[2], (DEPTH, D_MODEL, IN_WIDTH), f32) * D_MODEL ** -0.5
    sb_q_gain = 1.0 + 0.02 * jax.random.normal(ks[3], (DEPTH, SB_HEAD_DIM), f32)
    sb_k_gain = 1.0 + 0.02 * jax.random.normal(ks[4], (DEPTH, SB_HEAD_DIM), f32)
    sb_o_gain = 1.0 + 0.02 * jax.random.normal(ks[5], (DEPTH, SB_WIDTH), f32)
    gla_w_alpha = jax.random.normal(ks[6], (DEPTH, GLA_GATE_RANK, GLA_KEY_WIDTH), f32) * GLA_GATE_RANK ** -0.5
    gla_b_alpha = 0.1 * jax.random.normal(ks[7], (DEPTH, GLA_KEY_WIDTH), f32)
    gla_o_gain = 1.0 + 0.02 * jax.random.normal(ks[8], (DEPTH, GLA_VALUE_WIDTH), f32)
    w_out = jax.random.normal(ks[9], (DEPTH, D_MIX, D_MODEL), f32) * (0.5 * D_MIX ** -0.5)
    return {"x": x, "norm_gain": norm_gain, "w_in": w_in, "sb_q_gain": sb_q_gain,
            "sb_k_gain": sb_k_gain, "sb_o_gain": sb_o_gain, "gla_w_alpha": gla_w_alpha,
            "gla_b_alpha": gla_b_alpha, "gla_o_gain": gla_o_gain, "w_out": w_out}


def reference(x, norm_gain, w_in, sb_q_gain, sb_k_gain, sb_o_gain, gla_w_alpha,
              gla_b_alpha, gla_o_gain, w_out):
    offsets = np.cumsum(SPLIT_SIZES)[:-1].tolist()
    for layer in range(DEPTH):
        h = rms_norm(x, norm_gain[layer])
        proj = jnp.einsum('bsd,de->bse', h, w_in[layer])
        (sb_q, sb_k, sb_v, sb_g, gl_q, gl_k, gl_v, gl_g, gl_lr) = jnp.split(proj, offsets, axis=-1)

        q = rms_norm(to_heads(sb_q, SB_HEADS), sb_q_gain[layer])
        k = rms_norm(to_heads(sb_k, SB_HEADS), sb_k_gain[layer])
        v = to_heads(sb_v, SB_HEADS)
        a_out = stick_breaking_attention(q, k, v)
        a_out = rms_norm(a_out, sb_o_gain[layer].reshape(SB_HEADS, 1, SB_HEAD_DIM))
        a_out = from_heads(a_out) * jax.nn.silu(sb_g)

        gate_logits = jnp.einsum('bsr,rk->bsk', gl_lr, gla_w_alpha[layer]) + gla_b_alpha[layer]
        log_alpha = jax.nn.log_sigmoid(gate_logits.astype(jnp.float32)) / GLA_GATE_TAU
        b_out = gated_linear_attention(to_heads(gl_q, GLA_HEADS), to_heads(gl_k, GLA_HEADS),
                                       to_heads(gl_v, GLA_HEADS), to_heads(log_alpha, GLA_HEADS))
        b_out = rms_norm(b_out, gla_o_gain[layer].reshape(GLA_HEADS, 1, GLA_HEAD_V))
        b_out = from_heads(b_out) * jax.nn.silu(gl_g)

        mixed = jnp.concatenate([a_out, b_out], axis=-1)
        x = x + jnp.einsum('bse,ed->bsd', mixed, w_out[layer]).astype(x.dtype)
    return x
```

```cpp
#include <hip/hip_runtime.h>
#include <hip/hip_cooperative_groups.h>
#include <cstdio>
#include <cstdint>
namespace cg = cooperative_groups;
#ifndef DBG_SKIP_ATTN
#define DBG_SKIP_ATTN 0
#endif
#ifndef DBG_SKIP_GLA
#define DBG_SKIP_GLA 0
#endif
#ifndef DBG_SANITIZE
#define DBG_SANITIZE 0
#endif
#ifndef DBG_NO_INTER
#define DBG_NO_INTER 0
#endif
#ifndef DBG_RAW
#define DBG_RAW 0
#endif
#ifndef DBG_ZERO_CUM
#define DBG_ZERO_CUM 0
#endif
#ifndef DBG_NO_LOCAL
#define DBG_NO_LOCAL 0
#endif
#ifndef DBG_SKIP_MIX
#define DBG_SKIP_MIX 0
#endif
#ifndef MK_PER_PHASE
#define MK_PER_PHASE 1
#endif

namespace pg8 {
#define PG8_LAS __attribute__((address_space(3)))
typedef unsigned short bf16_t;
typedef short bf16x8 __attribute__((ext_vector_type(8)));
typedef float f32x4 __attribute__((ext_vector_type(4)));
typedef unsigned u32x4 __attribute__((ext_vector_type(4)));
constexpr int BM = 256, BK = 64, HALF = 128, HTB = HALF * BK * 2, STAGE_BYTES = 8 * HTB, NXCD = 8, WGM = 8;

__host__ __device__ __forceinline__ int lds_byte(int r, int c) { const int st = (r >> 4) * 2 + (c >> 5), rr = r & 15, cc = c & 31, ob = rr * 64 + cc * 2; return st * 1024 + (ob ^ (((ob >> 9) & 1) << 5)); }
__host__ __device__ __forceinline__ void stage_rc(int b, int& R, int& C) { const int st = b / 1024, sb = b % 1024, swz = sb ^ (((sb >> 9) & 1) << 5); R = (st >> 1) * 16 + swz / 64; C = (st & 1) * 32 + (swz % 64) / 2; }
__host__ __device__ __forceinline__ int perm32(int rho) { const int n = rho >> 4, i = rho & 15; return 8 * (i >> 2) + 4 * n + (i & 3); }

struct Unit { int pm, pn; };
struct Gemm { const bf16_t* A; const bf16_t* Bt; int M, N, K; };

struct StaticOrder {
    int nM, nN, nwg, G, c;
    __host__ __device__ void init(int M, int N, int G_, int c_) { nM = M / BM; nN = N / BM; nwg = nM * nN; G = G_; c = c_; }
    __host__ __device__ bool next(int i, Unit& u) const {
        const long L = (long)i * G + c; if (L >= nwg) return false;
        int wgid = (int)L; { const int q = nwg / NXCD, r = nwg % NXCD, xcd = wgid % NXCD, off = wgid / NXCD; wgid = (xcd < r ? xcd * (q + 1) : r * (q + 1) + (xcd - r) * q) + off; }
        const int nig = WGM * nN, gid = wgid / nig, fm = gid * WGM, gsz = (nM - fm) < WGM ? (nM - fm) : WGM;
        u.pm = fm + ((wgid % nig) % gsz); u.pn = (wgid % nig) / gsz; return true;
    }
    __device__ __forceinline__ void a_ready(const Unit&) const {}
    __device__ __forceinline__ void done(const Unit&) const {}
};

typedef float f32x2_t __attribute__((ext_vector_type(2)));
typedef __bf16 bf16x2_t __attribute__((ext_vector_type(2)));
__device__ __forceinline__ unsigned cvt_pk_bf16(float lo, float hi) { f32x2_t v = {lo, hi}; bf16x2_t b = __builtin_convertvector(v, bf16x2_t); return __builtin_bit_cast(unsigned, b); }

struct EpiBf16 {
    static constexpr bool PERM = true, AFTER_DRAIN = false;
    bf16_t* O; int ldc;
    __device__ __forceinline__ void operator()(const f32x4 (&acc)[2][2][4][2], const Unit& u, int wr, int wc, int fr, int fq) const {
        const int row0 = u.pm * BM + wr * 64 + fr; const int col0 = u.pn * BM + wc * 32 + 8 * fq;
#pragma unroll
        for (int ai = 0; ai < 2; ++ai)
#pragma unroll
            for (int m = 0; m < 4; ++m) { bf16_t* rowp = O + (size_t)(row0 + ai * HALF + m * 16) * ldc + col0;
#pragma unroll
                for (int bj = 0; bj < 2; ++bj) { const f32x4 v0 = acc[ai][bj][m][0], v1 = acc[ai][bj][m][1];
                    u32x4 w; w.x = cvt_pk_bf16(v0[0], v0[1]); w.y = cvt_pk_bf16(v0[2], v0[3]); w.z = cvt_pk_bf16(v1[0], v1[1]); w.w = cvt_pk_bf16(v1[2], v1[3]);
                    *(u32x4*)(rowp + bj * HALF) = w; } }
    }
};
struct EpiRes {
    static constexpr bool PERM = false, AFTER_DRAIN = false;
    const float* base; float* out; int ldc;
    __device__ __forceinline__ void operator()(const f32x4 (&acc)[2][2][4][2], const Unit& u, int wr, int wc, int fr, int fq) const {
        const int row0 = u.pm * BM + wr * 64 + fr; const int col0 = u.pn * BM + wc * 32 + 4 * fq;
#pragma unroll
        for (int ai = 0; ai < 2; ++ai)
#pragma unroll
            for (int m = 0; m < 4; ++m) { const size_t off = (size_t)(row0 + ai * HALF + m * 16) * ldc + col0;
#pragma unroll
                for (int bj = 0; bj < 2; ++bj)
#pragma unroll
                    for (int n = 0; n < 2; ++n) { const f32x4 b = *(const f32x4*)(base + off + bj * HALF + n * 16); *(f32x4*)(out + off + bj * HALF + n * 16) = b + acc[ai][bj][m][n]; } }
    }
};

template <class Epi, class Sched, bool ALIGN_EPI = false, bool SP2 = false>
__device__ __forceinline__ void gemm_phase(PG8_LAS unsigned char* lds, const Gemm g, const Sched& S, const Epi& E, const int tid) {
    const int wid = __builtin_amdgcn_readfirstlane(tid >> 6), lane = tid & 63, wr = wid >> 2, wc = wid & 3, fr = lane & 15, fq = lane >> 4;
    const int K = g.K, nt = K / BK;
    unsigned voffA[2], voffB[2];
#pragma unroll
    for (int i = 0; i < 2; ++i) { int R, C; stage_rc(tid * 16 + i * 8192, R, C); const int Rb = Epi::PERM ? ((R & ~31) + perm32(R & 31)) : R;
        voffA[i] = (unsigned)(R * K + C) * 2u; voffB[i] = (unsigned)(Rb * K + C) * 2u; }
    const size_t kstep = (size_t)(BK * 2);
    const size_t hstep = (size_t)HALF * K * 2;
    const size_t tstep = 2 * hstep;
    const unsigned ldsw = (unsigned)wid * 1024u;
    const int aoff = lds_byte(wr * 64 + fr, fq * 8), boff = lds_byte(wc * 32 + fr, fq * 8);
#define PG8_SA(b, h) (((b) * 2 + (h)) * HTB)
#define PG8_SB(b, h) ((4 + (b) * 2 + (h)) * HTB)
#define PG8_STAGE(bufoff, gbase, voff) do { _Pragma("unroll") for (int _i = 0; _i < 2; ++_i) \
        __builtin_amdgcn_global_load_lds((const unsigned*)((const char*)(gbase) + (voff)[_i]), (PG8_LAS unsigned*)(lds + (bufoff) + ldsw + _i * 8192), 16, 0, 0); } while (0)
#define PG8_LDA(dst, b, h) do { _Pragma("unroll") for (int m = 0; m < 4; ++m) _Pragma("unroll") for (int k = 0; k < 2; ++k) dst[m][k] = *(const PG8_LAS bf16x8*)(lds + PG8_SA(b, h) + aoff + m * 2048 + k * 1024); } while (0)
#define PG8_LDB(dst, b, h) do { _Pragma("unroll") for (int n = 0; n < 2; ++n) _Pragma("unroll") for (int k = 0; k < 2; ++k) dst[n][k] = *(const PG8_LAS bf16x8*)(lds + PG8_SB(b, h) + boff + n * 2048 + k * 1024); } while (0)
#define PG8_MMA(ai, bj, At, Bt) do { __builtin_amdgcn_s_setprio(1); _Pragma("unroll") for (int m = 0; m < 4; ++m) _Pragma("unroll") for (int n = 0; n < 2; ++n) _Pragma("unroll") for (int k = 0; k < 2; ++k) \
        acc[ai][bj][m][n] = __builtin_amdgcn_mfma_f32_16x16x32_bf16(Bt[n][k], At[m][k], acc[ai][bj][m][n], 0, 0, 0); __builtin_amdgcn_s_setprio(0); } while (0)
#define PG8_WAIT_V(n) asm volatile("s_waitcnt vmcnt(" #n ")" ::: "memory")
#define PG8_WAIT_L(n) asm volatile("s_waitcnt lgkmcnt(" #n ")" ::: "memory")
#define PG8_BAR __builtin_amdgcn_s_barrier()
#define PG8_SCHED __builtin_amdgcn_sched_barrier(0)
    Unit cur, nxt; int ui = 0;
    if (!S.next(0, cur)) return;
    f32x4 acc[2][2][4][2];
#pragma unroll
    for (int a = 0; a < 2; ++a)
#pragma unroll
        for (int b = 0; b < 2; ++b)
#pragma unroll
            for (int m = 0; m < 4; ++m)
#pragma unroll
                for (int n = 0; n < 2; ++n) acc[a][b][m][n] = (f32x4){0.f, 0.f, 0.f, 0.f};
    bf16x8 At[4][2], B0[2][2], B1[2][2];
    const char* cA = (const char*)g.A + (size_t)cur.pm * tstep; const char* cB = (const char*)g.Bt + (size_t)cur.pn * tstep;
    S.a_ready(cur);
    if constexpr (SP2) {
        PG8_STAGE(PG8_SB(0, 0), cB, voffB); PG8_STAGE(PG8_SB(0, 1), cB + hstep, voffB); PG8_STAGE(PG8_SA(0, 0), cA, voffA); PG8_STAGE(PG8_SA(0, 1), cA + hstep, voffA);
        if (wr == 1) PG8_BAR;
        PG8_WAIT_V(2); PG8_BAR;
        PG8_STAGE(PG8_SB(1, 0), cB + kstep, voffB); PG8_STAGE(PG8_SA(1, 0), cA + kstep, voffA); PG8_STAGE(PG8_SB(1, 1), cB + hstep + kstep, voffB);
        PG8_WAIT_V(6); PG8_BAR;
    } else {
        PG8_STAGE(PG8_SB(0, 0), cB, voffB); PG8_STAGE(PG8_SA(0, 0), cA, voffA); PG8_STAGE(PG8_SB(0, 1), cB + hstep, voffB); PG8_STAGE(PG8_SA(0, 1), cA + hstep, voffA);
        if (wr == 1) PG8_BAR;
        PG8_WAIT_V(4); PG8_BAR;
        PG8_STAGE(PG8_SB(1, 0), cB + kstep, voffB); PG8_STAGE(PG8_SA(1, 0), cA + kstep, voffA); PG8_STAGE(PG8_SB(1, 1), cB + hstep + kstep, voffB);
        PG8_WAIT_V(6); PG8_BAR;
    }
    for (;;) {
        const bool has_next = S.next(ui + 1, nxt);
        const char* nA = has_next ? (const char*)g.A + (size_t)nxt.pm * tstep : cA; const char* nB = has_next ? (const char*)g.Bt + (size_t)nxt.pn * tstep : cB;
        for (int t = 0; t < nt; t += 2) {
            const bool last = (t == nt - 2);
            const char* a1 = cA + (size_t)(t + 1) * kstep;
            const char* a2 = last ? nA : cA + (size_t)(t + 2) * kstep; const char* b2 = last ? nB : cB + (size_t)(t + 2) * kstep;
            const char* a3 = a2 + kstep; const char* b3 = b2 + kstep;
            if (last && has_next) S.a_ready(nxt);
            if constexpr (SP2) {
            PG8_LDB(B0, 0, 0); PG8_LDB(B1, 0, 1); PG8_SCHED; PG8_LDA(At, 0, 0); PG8_STAGE(PG8_SA(1, 1), a1 + hstep, voffA);
            PG8_WAIT_V(8); PG8_WAIT_L(0); PG8_BAR; PG8_MMA(0, 0, At, B0); PG8_MMA(0, 1, At, B1); PG8_BAR; PG8_SCHED;
            PG8_LDA(At, 0, 1); PG8_STAGE(PG8_SB(0, 0), b2, voffB); PG8_STAGE(PG8_SB(0, 1), b2 + hstep, voffB); PG8_STAGE(PG8_SA(0, 0), a2, voffA);
            PG8_WAIT_V(8); PG8_WAIT_L(0); PG8_BAR; PG8_MMA(1, 0, At, B0); PG8_MMA(1, 1, At, B1); PG8_BAR; PG8_SCHED;
            PG8_LDB(B0, 1, 0); PG8_LDB(B1, 1, 1); PG8_SCHED; PG8_LDA(At, 1, 0); PG8_STAGE(PG8_SA(0, 1), a2 + hstep, voffA);
            PG8_WAIT_V(8); PG8_WAIT_L(0); PG8_BAR; PG8_MMA(0, 0, At, B0); PG8_MMA(0, 1, At, B1); PG8_BAR; PG8_SCHED;
            PG8_LDA(At, 1, 1); PG8_STAGE(PG8_SB(1, 0), b3, voffB); PG8_STAGE(PG8_SB(1, 1), b3 + hstep, voffB); PG8_STAGE(PG8_SA(1, 0), a3, voffA);
            PG8_WAIT_V(8); PG8_WAIT_L(0); PG8_BAR; PG8_MMA(1, 0, At, B0); PG8_MMA(1, 1, At, B1); PG8_BAR; PG8_SCHED;
            } else {
            PG8_LDB(B0, 0, 0); PG8_SCHED; PG8_LDA(At, 0, 0); PG8_STAGE(PG8_SA(1, 1), a1 + hstep, voffA);
            PG8_WAIT_L(8); PG8_BAR; PG8_WAIT_L(0); PG8_MMA(0, 0, At, B0); PG8_BAR; PG8_SCHED;
            PG8_LDB(B1, 0, 1); PG8_STAGE(PG8_SB(0, 0), b2, voffB);
            PG8_BAR; PG8_WAIT_L(0); PG8_MMA(0, 1, At, B1); PG8_BAR;
            PG8_LDA(At, 0, 1); PG8_STAGE(PG8_SA(0, 0), a2, voffA);
            PG8_BAR; PG8_WAIT_L(0); PG8_MMA(1, 0, At, B0); PG8_BAR; PG8_SCHED;
            PG8_STAGE(PG8_SB(0, 1), b2 + hstep, voffB);
            PG8_WAIT_V(6); PG8_BAR; PG8_MMA(1, 1, At, B1); PG8_BAR;
            PG8_LDB(B0, 1, 0); PG8_SCHED; PG8_LDA(At, 1, 0); PG8_STAGE(PG8_SA(0, 1), a2 + hstep, voffA);
            PG8_WAIT_L(8); PG8_BAR; PG8_WAIT_L(0); PG8_MMA(0, 0, At, B0); PG8_BAR; PG8_SCHED;
            PG8_LDB(B1, 1, 1); PG8_STAGE(PG8_SB(1, 0), b3, voffB);
            PG8_BAR; PG8_WAIT_L(0); PG8_MMA(0, 1, At, B1); PG8_BAR;
            PG8_LDA(At, 1, 1); PG8_STAGE(PG8_SA(1, 0), a3, voffA);
            PG8_BAR; PG8_WAIT_L(0); PG8_MMA(1, 0, At, B0); PG8_BAR; PG8_SCHED;
            PG8_STAGE(PG8_SB(1, 1), b3 + hstep, voffB);
            PG8_WAIT_V(6); PG8_BAR; PG8_MMA(1, 1, At, B1); PG8_BAR;
            }
        }
        if constexpr (ALIGN_EPI) { if (wr == 0) PG8_BAR; }
        if constexpr (!Epi::AFTER_DRAIN) { E(acc, cur, wr, wc, fr, fq); S.done(cur); }
        if (!has_next) break;
#pragma unroll
        for (int a = 0; a < 2; ++a)
#pragma unroll
            for (int b = 0; b < 2; ++b)
#pragma unroll
                for (int m = 0; m < 4; ++m)
#pragma unroll
                    for (int n = 0; n < 2; ++n) acc[a][b][m][n] = (f32x4){0.f, 0.f, 0.f, 0.f};
        cur = nxt; cA = nA; cB = nB; ++ui;
        if constexpr (ALIGN_EPI) { if (wr == 1) PG8_BAR; }
    }
    PG8_WAIT_V(0);
    if constexpr (!ALIGN_EPI) { if (wr == 0) PG8_BAR; }
    PG8_BAR;
#undef PG8_SA
#undef PG8_SB
#undef PG8_STAGE
#undef PG8_LDA
#undef PG8_LDB
#undef PG8_MMA
#undef PG8_WAIT_V
#undef PG8_WAIT_L
#undef PG8_BAR
#undef PG8_SCHED
}
}

#define LAS __attribute__((address_space(3)))
typedef unsigned short bf16;
typedef short bf16x8 __attribute__((ext_vector_type(8)));
typedef float f32x4 __attribute__((ext_vector_type(4)));
typedef unsigned u32x4 __attribute__((ext_vector_type(4)));
typedef unsigned u32x2 __attribute__((ext_vector_type(2)));

constexpr int NWAVES = 8, NTHR = 512;
constexpr int BATCH = 4, SEQ = 4096, DM = 2048, DEPTH = 2;
constexpr int M = BATCH * SEQ;
constexpr int INW = 7184;
constexpr int NP = 7680;
constexpr int C_SBQ = 0, C_SBK = 1024, C_SBV = 2048, C_SBG = 3072, C_GLQ = 4096, C_GLK = 4608, C_GLV = 5120, C_GLG = 6144, C_GATE = 7168;
constexpr float EPS = 1e-6f;
constexpr int NCHUNK = 64;
constexpr size_t MiB = 1u << 20;
constexpr size_t WS_WIN = 2 * MiB, WIN_L = (size_t)NP * DM * 2;
constexpr size_t WS_WOUT = 62 * MiB, WOUT_L = (size_t)DM * DM * 2;
constexpr size_t WS_PROJ = 80 * MiB;
constexpr size_t WS_XN = 320 * MiB;
constexpr size_t WS_KV = 384 * MiB;
constexpr size_t WS_DN = 448 * MiB;
constexpr size_t WS_END = 449 * MiB;
constexpr int LDS_BYTES = 147456;

__device__ __forceinline__ unsigned pk2(float lo, float hi) { return pg8::cvt_pk_bf16(lo, hi); }
__device__ __forceinline__ unsigned short f2bf(float f) { return (unsigned short)(pk2(f, 0.f) & 0xffffu); }
__device__ __forceinline__ float bf2f(unsigned short v) { return __uint_as_float((unsigned)v << 16); }
__device__ __forceinline__ float lo_f(unsigned w) { return __uint_as_float(w << 16); }
__device__ __forceinline__ float hi_f(unsigned w) { return __uint_as_float(w & 0xffff0000u); }
__device__ __forceinline__ float wave_sum(float v) {
#pragma unroll
    for (int o = 1; o < 64; o <<= 1) v += __shfl_xor(v, o);
    return v;
}
__device__ __forceinline__ float silu(float g) { return g / (1.f + __expf(-g)); }
__device__ __forceinline__ float softplus(float z) { return fmaxf(z, 0.f) + __logf(1.f + __expf(-fabsf(z))); }
#define LDS_WAIT() asm volatile("s_waitcnt lgkmcnt(0)" ::: "memory")
#define MFMA16(a, b, c) __builtin_amdgcn_mfma_f32_16x16x32_bf16((a), (b), (c), 0, 0, 0)

struct Ptrs {
    const float* x; const float* norm_gain; const float* w_in; const float* qg; const float* kg; const float* og; const float* wa; const float* ba; const float* gg; const float* w_out;
    float* out; unsigned char* ws;
};

__device__ __forceinline__ void transpose_item(const float* W, int ldw, int nblk, int K, bf16* WT, LAS float* scr, int item, int lane) {
    const int kb = item / nblk, nb = item % nblk, k0 = 64 * kb, n0 = 32 * nb;
#pragma unroll 8
    for (int i = 0; i < 32; ++i) { const int kk = 2 * i + (lane >> 5); scr[kk * 33 + (lane & 31)] = W[(size_t)(k0 + kk) * ldw + n0 + (lane & 31)]; }
    LDS_WAIT(); asm volatile("" ::: "memory");
    const int c = lane & 7;
#pragma unroll
    for (int j = 0; j < 4; ++j) { const int n = (lane >> 3) + 8 * j; const LAS float* s = scr + (8 * c) * 33 + n;
        u32x4 o; o.x = pk2(s[0 * 33], s[1 * 33]); o.y = pk2(s[2 * 33], s[3 * 33]); o.z = pk2(s[4 * 33], s[5 * 33]); o.w = pk2(s[6 * 33], s[7 * 33]);
        *(u32x4*)(WT + (size_t)(n0 + n) * K + k0 + 8 * c) = o; }
    LDS_WAIT(); asm volatile("" ::: "memory");
}

__device__ __forceinline__ void phase_weights(const Ptrs& P, LAS unsigned char* lds, int G, const int tid, const int bid) {
    const int lane = tid & 63, wave = tid >> 6;
    LAS float* scr = (LAS float*)(lds + wave * 16384);
    const int gw = bid * NWAVES + wave, NGW = G * NWAVES;
    constexpr int I_IN = (DM / 64) * (7168 / 32), I_OUT = (DM / 64) * (DM / 32);
    for (int it = gw; it < DEPTH * (I_IN + I_OUT); it += NGW) {
        const int l = it / (I_IN + I_OUT); int r = it % (I_IN + I_OUT);
        if (r < I_IN) transpose_item(P.w_in + (size_t)l * DM * INW, INW, 7168 / 32, DM, (bf16*)(P.ws + WS_WIN + l * WIN_L), scr, r, lane);
        else transpose_item(P.w_out + (size_t)l * DM * DM, DM, DM / 32, DM, (bf16*)(P.ws + WS_WOUT + l * WOUT_L), scr, r - I_IN, lane);
    }
    const int gt = bid * NTHR + tid, NGT = G * NTHR;
    for (int it = gt; it < DEPTH * 512 * 256; it += NGT) {
        const int l = it / (512 * 256), r2 = it % (512 * 256), k = r2 >> 8, d0 = (r2 & 255) * 8;
        const float* wl = P.w_in + (size_t)l * DM * INW + 7168;
        const float* wa = P.wa + (size_t)l * 16 * 512 + k;
        float a[16];
#pragma unroll
        for (int r = 0; r < 16; ++r) a[r] = wa[r * 512];
        float o[8];
#pragma unroll
        for (int j = 0; j < 8; ++j) { const f32x4* wr = (const f32x4*)(wl + (size_t)(d0 + j) * INW); float s = 0.f;
#pragma unroll
            for (int q = 0; q < 4; ++q) { const f32x4 w = wr[q]; s += w[0] * a[4 * q] + w[1] * a[4 * q + 1] + w[2] * a[4 * q + 2] + w[3] * a[4 * q + 3]; }
            o[j] = s; }
        u32x4 w; w.x = pk2(o[0], o[1]); w.y = pk2(o[2], o[3]); w.z = pk2(o[4], o[5]); w.w = pk2(o[6], o[7]);
        *(u32x4*)((bf16*)(P.ws + WS_WIN + l * WIN_L) + (size_t)(7168 + k) * DM + d0) = w;
    }
}

__device__ __forceinline__ void phase_rownorm(const Ptrs& P, const float* xin, int layer, int G, const int tid, const int bid) {
    const int lane = tid & 63, wave = tid >> 6;
    const int gw = bid * NWAVES + wave, NGW = G * NWAVES;
    const f32x4* gp = (const f32x4*)(P.norm_gain + layer * DM) + lane;
    bf16* XN = (bf16*)(P.ws + WS_XN);
    for (int m = gw; m < M; m += NGW) {
        const f32x4* xr = (const f32x4*)(xin + (size_t)m * DM) + lane;
        f32x4 v[8]; float s = 0.f;
#pragma unroll
        for (int j = 0; j < 8; ++j) { v[j] = xr[64 * j]; s += (v[j][0] * v[j][0] + v[j][1] * v[j][1]) + (v[j][2] * v[j][2] + v[j][3] * v[j][3]); }
        const float rs = rsqrtf(wave_sum(s) * (1.f / DM) + EPS);
        u32x2* o8 = (u32x2*)(XN + (size_t)m * DM) + lane;
#pragma unroll
        for (int j = 0; j < 8; ++j) { const f32x4 g = gp[64 * j]; u32x2 w; w.x = pk2(v[j][0] * rs * g[0], v[j][1] * rs * g[1]); w.y = pk2(v[j][2] * rs * g[2], v[j][3] * rs * g[3]); o8[64 * j] = w; }
    }
}

constexpr int AQ_LD = 136, AV_LD = 72, AS_LD = 68;
constexpr int A_QS = 0, A_KS = A_QS + 128 * AQ_LD * 2, A_VT = A_KS + 64 * AQ_LD * 2, A_SZ = A_VT + 128 * AV_LD * 2, A_PS = A_SZ + 128 * AS_LD * 4, A_END = A_PS + 128 * AV_LD * 2;
static_assert(A_END <= 131072, "attention LDS");
constexpr float SB_STOP = -105.0f;

__device__ __forceinline__ void attn_unit(const Ptrs& P, LAS unsigned char* lds, int layer, int u, const int tid) {
    const int lane = tid & 63, w = __builtin_amdgcn_readfirstlane(tid >> 6), fr = lane & 15, fq = lane >> 4;
    const int bh = u >> 5, qb = u & 31, b = bh >> 3, h = bh & 7;
    const int t0 = qb * 128, rowbase = b * SEQ;
    const bf16* PR = (const bf16*)(P.ws + WS_PROJ);
    bf16* MIX = (bf16*)(P.ws + WS_XN);
    LAS bf16* Qs = (LAS bf16*)(lds + A_QS); LAS bf16* Ks = (LAS bf16*)(lds + A_KS); LAS bf16* Vt = (LAS bf16*)(lds + A_VT);
    LAS float* Sz = (LAS float*)(lds + A_SZ); LAS bf16* Ps = (LAS bf16*)(lds + A_PS);
    __syncthreads();
    {
        const int r = tid >> 2, part = tid & 3;
        const u32x4* src = (const u32x4*)(PR + (size_t)(rowbase + t0 + r) * NP + C_SBQ + h * 128 + part * 32);
        u32x4 wv[4]; float v[32]; float ss = 0.f;
#pragma unroll
        for (int j = 0; j < 4; ++j) wv[j] = src[j];
#pragma unroll
        for (int j = 0; j < 4; ++j)
#pragma unroll
            for (int e = 0; e < 4; ++e) { v[8 * j + 2 * e] = lo_f(wv[j][e]); v[8 * j + 2 * e + 1] = hi_f(wv[j][e]); }
#pragma unroll
        for (int j = 0; j < 32; ++j) ss += v[j] * v[j];
        ss += __shfl_xor(ss, 1); ss += __shfl_xor(ss, 2);
        const float rs = rsqrtf(ss * (1.f / 128.f) + EPS) * 0.08838834764831845f;
        const float* g = P.qg + layer * 128 + part * 32;
#pragma unroll
        for (int j = 0; j < 4; ++j) { u32x4 o;
#pragma unroll
            for (int e = 0; e < 4; ++e) o[e] = pk2(v[8 * j + 2 * e] * rs * g[8 * j + 2 * e], v[8 * j + 2 * e + 1] * rs * g[8 * j + 2 * e + 1]);
            *(LAS u32x4*)(Qs + r * AQ_LD + part * 32 + 8 * j) = o; }
    }
    f32x4 oacc[8];
#pragma unroll
    for (int n = 0; n < 8; ++n) oacc[n] = (f32x4){0.f, 0.f, 0.f, 0.f};
    float carry = 0.f;
    for (int kt = 2 * qb + 1; kt >= 0; --kt) {
        __syncthreads();
        {
            const int r = tid >> 3, part = tid & 7;
            const size_t rowoff = (size_t)(rowbase + kt * 64 + r) * NP + h * 128 + part * 16;
            const u32x4* ks = (const u32x4*)(PR + rowoff + C_SBK); const u32x4* vs = (const u32x4*)(PR + rowoff + C_SBV);
            const u32x4 k0 = ks[0], k1 = ks[1], v0 = vs[0], v1 = vs[1];
            float kv[16]; float ss = 0.f;
#pragma unroll
            for (int e = 0; e < 4; ++e) { kv[2 * e] = lo_f(k0[e]); kv[2 * e + 1] = hi_f(k0[e]); kv[8 + 2 * e] = lo_f(k1[e]); kv[8 + 2 * e + 1] = hi_f(k1[e]); }
#pragma unroll
            for (int j = 0; j < 16; ++j) ss += kv[j] * kv[j];
            ss += __shfl_xor(ss, 1); ss += __shfl_xor(ss, 2); ss += __shfl_xor(ss, 4);
            const float rs = rsqrtf(ss * (1.f / 128.f) + EPS);
            const float* g = P.kg + layer * 128 + part * 16;
            u32x4 o0, o1;
#pragma unroll
            for (int e = 0; e < 4; ++e) { o0[e] = pk2(kv[2 * e] * rs * g[2 * e], kv[2 * e + 1] * rs * g[2 * e + 1]); o1[e] = pk2(kv[8 + 2 * e] * rs * g[8 + 2 * e], kv[8 + 2 * e + 1] * rs * g[8 + 2 * e + 1]); }
            *(LAS u32x4*)(Ks + r * AQ_LD + part * 16) = o0; *(LAS u32x4*)(Ks + r * AQ_LD + part * 16 + 8) = o1;
#pragma unroll
            for (int e = 0; e < 4; ++e) {
                Vt[(part * 16 + 2 * e) * AV_LD + r] = (bf16)(v0[e] & 0xffffu); Vt[(part * 16 + 2 * e + 1) * AV_LD + r] = (bf16)(v0[e] >> 16);
                Vt[(part * 16 + 8 + 2 * e) * AV_LD + r] = (bf16)(v1[e] & 0xffffu); Vt[(part * 16 + 8 + 2 * e + 1) * AV_LD + r] = (bf16)(v1[e] >> 16); }
        }
        __syncthreads();
        {
            f32x4 acc[4];
#pragma unroll
            for (int n = 0; n < 4; ++n) acc[n] = (f32x4){0.f, 0.f, 0.f, 0.f};
#pragma unroll
            for (int ks = 0; ks < 4; ++ks) { const bf16x8 a = *(const LAS bf16x8*)(Qs + (16 * w + fr) * AQ_LD + ks * 32 + fq * 8);
#pragma unroll
                for (int n = 0; n < 4; ++n) { const bf16x8 bb = *(const LAS bf16x8*)(Ks + (16 * n + fr) * AQ_LD + ks * 32 + fq * 8); acc[n] = MFMA16(a, bb, acc[n]); } }
#pragma unroll
            for (int n = 0; n < 4; ++n)
#pragma unroll
                for (int i = 0; i < 4; ++i) Sz[(16 * w + 4 * fq + i) * AS_LD + 16 * n + fr] = acc[n][i];
        }
        __syncthreads();
        int done;
        {
            const int r = tid >> 2, seg = tid & 3; const int tq = t0 + r, kbase = kt * 64 + seg * 16;
            float z[16], sp[16]; float total = 0.f;
#pragma unroll
            for (int j4 = 0; j4 < 4; ++j4) { const f32x4 zz = *(const LAS f32x4*)(Sz + r * AS_LD + seg * 16 + 4 * j4); z[4 * j4] = zz[0]; z[4 * j4 + 1] = zz[1]; z[4 * j4 + 2] = zz[2]; z[4 * j4 + 3] = zz[3]; }
#pragma unroll
            for (int j = 0; j < 16; ++j) { const bool valid = (kbase + j) < tq; sp[j] = softplus(z[j]); total += valid ? -sp[j] : 0.f; }
            const int lb = lane & ~3;
            const float s0 = __shfl(total, lb), s1 = __shfl(total, lb + 1), s2 = __shfl(total, lb + 2), s3 = __shfl(total, lb + 3);
            float running = carry + (seg < 3 ? s3 : 0.f) + (seg < 2 ? s2 : 0.f) + (seg < 1 ? s1 : 0.f);
            float p[16];
#pragma unroll
            for (int j = 15; j >= 0; --j) { const bool valid = (kbase + j) < tq; p[j] = valid ? __expf(z[j] - sp[j] + running) : 0.f; running += valid ? -sp[j] : 0.f; }
            carry += (s0 + s1) + (s2 + s3);
            u32x4 o0, o1;
#pragma unroll
            for (int e = 0; e < 4; ++e) { o0[e] = pk2(p[2 * e], p[2 * e + 1]); o1[e] = pk2(p[8 + 2 * e], p[8 + 2 * e + 1]); }
            *(LAS u32x4*)(Ps + r * AV_LD + seg * 16) = o0; *(LAS u32x4*)(Ps + r * AV_LD + seg * 16 + 8) = o1;
            done = carry < SB_STOP;
        }
        const int alldone = __syncthreads_and(done);
        {
#pragma unroll
            for (int ks = 0; ks < 2; ++ks) { const bf16x8 a = *(const LAS bf16x8*)(Ps + (16 * w + fr) * AV_LD + ks * 32 + fq * 8);
#pragma unroll
                for (int n = 0; n < 8; ++n) { const bf16x8 bb = *(const LAS bf16x8*)(Vt + (16 * n + fr) * AV_LD + ks * 32 + fq * 8); oacc[n] = MFMA16(a, bb, oacc[n]); } }
        }
        if (alldone) break;
    }
#pragma unroll
    for (int i = 0; i < 4; ++i) {
        float ss = 0.f;
#pragma unroll
        for (int n = 0; n < 8; ++n) ss += oacc[n][i] * oacc[n][i];
        ss += __shfl_xor(ss, 1); ss += __shfl_xor(ss, 2); ss += __shfl_xor(ss, 4); ss += __shfl_xor(ss, 8);
        const float rs = rsqrtf(ss * (1.f / 128.f) + EPS);
        const size_t m = (size_t)(rowbase + t0 + 16 * w + 4 * fq + i);
#pragma unroll
        for (int n = 0; n < 8; ++n) { const int d = h * 128 + 16 * n + fr; const float g = bf2f(PR[m * NP + C_SBG + d]);
            MIX[m * DM + d] = f2bf(oacc[n][i] * rs * P.og[layer * 1024 + d] * silu(g)); }
    }
}

constexpr int G_CUM = 0, G_PS = 126976, G_QD = 64 * 132 * 4, G_KI = G_QD + 64 * 136 * 2, G_KDT = G_KI + 64 * 136 * 2, G_VT = G_KDT + 128 * 72 * 2, G_TOT = G_VT + 256 * 72 * 2, G_END = G_TOT + 4 * 128 * 4;
static_assert(G_END <= G_PS && G_PS + 64 * 72 * 2 <= LDS_BYTES, "gla LDS");

__device__ __forceinline__ void gla_local_unit(const Ptrs& P, LAS unsigned char* lds, int layer, int u, const int tid) {
    const int lane = tid & 63, w = __builtin_amdgcn_readfirstlane(tid >> 6), fr = lane & 15, fq = lane >> 4;
    const int bh = u >> 6, n = u & 63, b = bh >> 2, h = bh & 3;
    const size_t m0 = (size_t)b * SEQ + n * 64;
    bf16* PR = (bf16*)(P.ws + WS_PROJ);
    bf16* KVT = (bf16*)(P.ws + WS_KV) + (size_t)u * 32768;
    float* DN = (float*)(P.ws + WS_DN) + (size_t)u * 128;
    LAS float* CUM = (LAS float*)(lds + G_CUM); LAS bf16* Ps = (LAS bf16*)(lds + G_PS); LAS bf16* Qd = (LAS bf16*)(lds + G_QD); LAS bf16* Ki = (LAS bf16*)(lds + G_KI);
    LAS bf16* KdT = (LAS bf16*)(lds + G_KDT); LAS bf16* VT = (LAS bf16*)(lds + G_VT); LAS float* TOT = (LAS float*)(lds + G_TOT);
    __syncthreads();
    {
        const int c = tid & 127, tq = tid >> 7;
        const float bias = P.ba[layer * 512 + h * 128 + c];
        float cs[16]; float run = 0.f;
#pragma unroll
        for (int j = 0; j < 16; ++j) { const float xg = bf2f(PR[(m0 + tq * 16 + j) * NP + C_GATE + h * 128 + c]) + bias;
            const float la = (fminf(xg, 0.f) - __logf(1.f + __expf(-fabsf(xg)))) * (1.f / 16.f); run += la; cs[j] = run; }
        TOT[tq * 128 + c] = run;
        __syncthreads();
        float off = 0.f;
#pragma unroll
        for (int s = 0; s < 3; ++s) off += (s < tq) ? TOT[s * 128 + c] : 0.f;
#pragma unroll
        for (int j = 0; j < 16; ++j) CUM[(tq * 16 + j) * 132 + c] = DBG_ZERO_CUM ? 0.f : cs[j] + off;
    }
    __syncthreads();
    {
        const int t = tid >> 3, part = tid & 7, c0 = part * 16;
        bf16* qp = PR + (m0 + t) * NP + C_GLQ + h * 128 + c0; const bf16* kp = PR + (m0 + t) * NP + C_GLK + h * 128 + c0;
        const u32x4 q0 = ((const u32x4*)qp)[0], q1 = ((const u32x4*)qp)[1], k0 = ((const u32x4*)kp)[0], k1 = ((const u32x4*)kp)[1];
        float qv[16], kv[16];
#pragma unroll
        for (int e = 0; e < 4; ++e) { qv[2 * e] = lo_f(q0[e]); qv[2 * e + 1] = hi_f(q0[e]); qv[8 + 2 * e] = lo_f(q1[e]); qv[8 + 2 * e + 1] = hi_f(q1[e]);
                                      kv[2 * e] = lo_f(k0[e]); kv[2 * e + 1] = hi_f(k0[e]); kv[8 + 2 * e] = lo_f(k1[e]); kv[8 + 2 * e + 1] = hi_f(k1[e]); }
        float qd[16], ki[16], kd[16];
#pragma unroll
        for (int j = 0; j < 16; ++j) { const float cu = CUM[t * 132 + c0 + j], cl = CUM[63 * 132 + c0 + j];
            qd[j] = qv[j] * 0.08838834764831845f * __expf(cu); ki[j] = kv[j] * __expf(-cu); kd[j] = kv[j] * __expf(cl - cu);
            if (t == 63) DN[c0 + j] = __expf(cl); }
        u32x4 a0, a1, b0, b1;
#pragma unroll
        for (int e = 0; e < 4; ++e) { a0[e] = pk2(qd[2 * e], qd[2 * e + 1]); a1[e] = pk2(qd[8 + 2 * e], qd[8 + 2 * e + 1]); b0[e] = pk2(ki[2 * e], ki[2 * e + 1]); b1[e] = pk2(ki[8 + 2 * e], ki[8 + 2 * e + 1]); }
        *(LAS u32x4*)(Qd + t * 136 + c0) = a0; *(LAS u32x4*)(Qd + t * 136 + c0 + 8) = a1;
        *(LAS u32x4*)(Ki + t * 136 + c0) = b0; *(LAS u32x4*)(Ki + t * 136 + c0 + 8) = b1;
        ((u32x4*)qp)[0] = a0; ((u32x4*)qp)[1] = a1;
#pragma unroll
        for (int j = 0; j < 16; ++j) KdT[(c0 + j) * 72 + t] = f2bf(kd[j]);
        const int dv0 = part * 32;
        const u32x4* vp = (const u32x4*)(PR + (m0 + t) * NP + C_GLV + h * 256 + dv0);
#pragma unroll
        for (int j = 0; j < 4; ++j) { const u32x4 vv = vp[j];
#pragma unroll
            for (int e = 0; e < 4; ++e) { VT[(dv0 + 8 * j + 2 * e) * 72 + t] = (bf16)(vv[e] & 0xffffu); VT[(dv0 + 8 * j + 2 * e + 1) * 72 + t] = (bf16)(vv[e] >> 16); } }
    }
    __syncthreads();
    {
        const int rt = w >> 1, ctb = (w & 1) * 2;
        f32x4 acc[2] = {(f32x4){0.f, 0.f, 0.f, 0.f}, (f32x4){0.f, 0.f, 0.f, 0.f}};
#pragma unroll
        for (int ks = 0; ks < 4; ++ks) { const bf16x8 a = *(const LAS bf16x8*)(Qd + (16 * rt + fr) * 136 + ks * 32 + fq * 8);
#pragma unroll
            for (int j = 0; j < 2; ++j) { const bf16x8 bb = *(const LAS bf16x8*)(Ki + (16 * (ctb + j) + fr) * 136 + ks * 32 + fq * 8); acc[j] = MFMA16(a, bb, acc[j]); } }
#pragma unroll
        for (int j = 0; j < 2; ++j)
#pragma unroll
            for (int i = 0; i < 4; ++i) { const int c = 16 * rt + 4 * fq + i, e = 16 * (ctb + j) + fr; Ps[c * 72 + e] = f2bf(e <= c ? acc[j][i] : 0.f); }
    }
    __syncthreads();
    {
        bf16x8 bv[2][2];
#pragma unroll
        for (int ks = 0; ks < 2; ++ks)
#pragma unroll
            for (int j = 0; j < 2; ++j) bv[ks][j] = *(const LAS bf16x8*)(VT + (16 * (2 * w + j) + fr) * 72 + ks * 32 + fq * 8);
        {
            f32x4 oi[4][2];
#pragma unroll
            for (int rt = 0; rt < 4; ++rt) { oi[rt][0] = (f32x4){0.f, 0.f, 0.f, 0.f}; oi[rt][1] = (f32x4){0.f, 0.f, 0.f, 0.f}; }
#pragma unroll
            for (int ks = 0; ks < 2; ++ks)
#pragma unroll
                for (int rt = 0; rt < 4; ++rt) { const bf16x8 a = *(const LAS bf16x8*)(Ps + (16 * rt + fr) * 72 + ks * 32 + fq * 8);
                    oi[rt][0] = MFMA16(a, bv[ks][0], oi[rt][0]); oi[rt][1] = MFMA16(a, bv[ks][1], oi[rt][1]); }
#pragma unroll
            for (int rt = 0; rt < 4; ++rt)
#pragma unroll
                for (int j = 0; j < 2; ++j)
#pragma unroll
                    for (int i = 0; i < 4; ++i) PR[(m0 + 16 * rt + 4 * fq + i) * NP + C_GLV + h * 256 + 16 * (2 * w + j) + fr] = f2bf(oi[rt][j][i]);
        }
        {
#pragma unroll
            for (int rt = 0; rt < 8; ++rt) {
                f32x4 k0 = (f32x4){0.f, 0.f, 0.f, 0.f}, k1 = (f32x4){0.f, 0.f, 0.f, 0.f};
#pragma unroll
                for (int ks = 0; ks < 2; ++ks) { const bf16x8 a = *(const LAS bf16x8*)(KdT + (16 * rt + fr) * 72 + ks * 32 + fq * 8); k0 = MFMA16(a, bv[ks][0], k0); k1 = MFMA16(a, bv[ks][1], k1); }
                u32x2 s0, s1; s0.x = pk2(k0[0], k0[1]); s0.y = pk2(k0[2], k0[3]); s1.x = pk2(k1[0], k1[1]); s1.y = pk2(k1[2], k1[3]);
                *(u32x2*)(KVT + (size_t)(16 * (2 * w) + fr) * 128 + 16 * rt + 4 * fq) = s0;
                *(u32x2*)(KVT + (size_t)(16 * (2 * w + 1) + fr) * 128 + 16 * rt + 4 * fq) = s1;
            }
        }
    }
}

__device__ __forceinline__ void gla_scan(const Ptrs& P, int idx) {
    const int bh = idx >> 12, e8 = idx & 4095, dk0 = (e8 & 15) * 8;
    bf16* base = (bf16*)(P.ws + WS_KV) + (size_t)bh * NCHUNK * 32768 + (size_t)e8 * 8;
    const float* dn = (const float*)(P.ws + WS_DN) + (size_t)bh * NCHUNK * 128 + dk0;
    float S[8];
#pragma unroll
    for (int j = 0; j < 8; ++j) S[j] = 0.f;
    for (int n0 = 0; n0 < NCHUNK; n0 += 4) {
        u32x4 kv[4]; f32x4 d0[4], d1[4];
#pragma unroll
        for (int q = 0; q < 4; ++q) { kv[q] = *(const u32x4*)(base + (size_t)(n0 + q) * 32768); d0[q] = *(const f32x4*)(dn + (n0 + q) * 128); d1[q] = *(const f32x4*)(dn + (n0 + q) * 128 + 4); }
#pragma unroll
        for (int q = 0; q < 4; ++q) {
            u32x4 o; o.x = pk2(S[0], S[1]); o.y = pk2(S[2], S[3]); o.z = pk2(S[4], S[5]); o.w = pk2(S[6], S[7]);
            *(u32x4*)(base + (size_t)(n0 + q) * 32768) = o;
#pragma unroll
            for (int e = 0; e < 4; ++e) { const float dlo = e < 2 ? d0[q][2 * e] : d1[q][2 * e - 4], dhi = e < 2 ? d0[q][2 * e + 1] : d1[q][2 * e - 3];
                S[2 * e] = dlo * S[2 * e] + lo_f(kv[q][e]); S[2 * e + 1] = dhi * S[2 * e + 1] + hi_f(kv[q][e]); }
        }
    }
}

__device__ __forceinline__ void gla_out_unit(const Ptrs& P, LAS unsigned char* lds, int layer, int u, const int tid) {
    const int lane = tid & 63, w = __builtin_amdgcn_readfirstlane(tid >> 6), fr = lane & 15, fq = lane >> 4;
    const int bh = u >> 6, n = u & 63, b = bh >> 2, h = bh & 3;
    const size_t m0 = (size_t)b * SEQ + n * 64;
    const bf16* PR = (const bf16*)(P.ws + WS_PROJ);
    const bf16* KVT = (const bf16*)(P.ws + WS_KV) + (size_t)u * 32768;
    bf16* MIX = (bf16*)(P.ws + WS_XN);
    LAS float* SS = (LAS float*)lds;
    __syncthreads();
    f32x4 acc[4][2];
#pragma unroll
    for (int rt = 0; rt < 4; ++rt) { acc[rt][0] = (f32x4){0.f, 0.f, 0.f, 0.f}; acc[rt][1] = (f32x4){0.f, 0.f, 0.f, 0.f}; }
#pragma unroll
    for (int ks = 0; ks < 4; ++ks) {
        const bf16x8 b0 = *(const bf16x8*)(KVT + (size_t)(16 * (2 * w) + fr) * 128 + ks * 32 + fq * 8);
        const bf16x8 b1 = *(const bf16x8*)(KVT + (size_t)(16 * (2 * w + 1) + fr) * 128 + ks * 32 + fq * 8);
#pragma unroll
        for (int rt = 0; rt < 4; ++rt) { if (DBG_NO_INTER) break; const bf16x8 a = *(const bf16x8*)(PR + (m0 + 16 * rt + fr) * NP + C_GLQ + h * 128 + ks * 32 + fq * 8);
            acc[rt][0] = MFMA16(a, b0, acc[rt][0]); acc[rt][1] = MFMA16(a, b1, acc[rt][1]); }
    }
#pragma unroll
    for (int rt = 0; rt < 4; ++rt)
#pragma unroll
        for (int i = 0; i < 4; ++i) { const size_t m = m0 + 16 * rt + 4 * fq + i; float ss = 0.f;
#pragma unroll
            for (int j = 0; j < 2; ++j) { acc[rt][j][i] += bf2f(PR[m * NP + C_GLV + h * 256 + 16 * (2 * w + j) + fr]); ss += acc[rt][j][i] * acc[rt][j][i]; }
            ss += __shfl_xor(ss, 1); ss += __shfl_xor(ss, 2); ss += __shfl_xor(ss, 4); ss += __shfl_xor(ss, 8);
            if (fr == 0) SS[(16 * rt + 4 * fq + i) * 8 + w] = ss; }
    __syncthreads();
#pragma unroll
    for (int rt = 0; rt < 4; ++rt)
#pragma unroll
        for (int i = 0; i < 4; ++i) { const int r = 16 * rt + 4 * fq + i; const size_t m = m0 + r;
            const f32x4 sa = *(const LAS f32x4*)(SS + r * 8), sb = *(const LAS f32x4*)(SS + r * 8 + 4);
            const float tot = ((sa[0] + sa[1]) + (sa[2] + sa[3])) + ((sb[0] + sb[1]) + (sb[2] + sb[3]));
            const float rs = rsqrtf(tot * (1.f / 256.f) + EPS);
#pragma unroll
            for (int j = 0; j < 2; ++j) { const int dv = h * 256 + 16 * (2 * w + j) + fr; const float g = bf2f(PR[m * NP + C_GLG + dv]);
                float ov = acc[rt][j][i] * rs * P.gg[layer * 1024 + dv] * silu(g); if (DBG_RAW) { const int dl = 16 * (2 * w + j) + fr; ov = bf2f(PR[m * NP + C_GLV + dv]) + bf2f(PR[m * NP + C_GATE + h * 128 + (dl & 127)]) + bf2f(PR[m * NP + C_GLQ + h * 128 + (dl & 127)]) + bf2f(PR[m * NP + C_GLK + h * 128 + (dl & 127)]); } if (DBG_SANITIZE && !(fabsf(ov) < 1e30f)) ov = 0.f; MIX[m * DM + 1024 + dv] = f2bf(ov); } }
}

__device__ __forceinline__ void grid_barrier(cg::grid_group& grid) {
    __builtin_amdgcn_fence(__ATOMIC_RELEASE, "agent");
    asm volatile("s_waitcnt vmcnt(0) lgkmcnt(0)" ::: "memory");
    grid.sync();
    __builtin_amdgcn_fence(__ATOMIC_ACQUIRE, "agent");
    asm volatile("s_waitcnt vmcnt(0) lgkmcnt(0)" ::: "memory");
    __syncthreads();
}
struct Args { const float* in[10]; float* out; unsigned char* ws; int ph_lo, ph_hi; };
constexpr int PH_PER_LAYER = 6, N_PHASES = DEPTH * PH_PER_LAYER;

__global__ void __launch_bounds__(NTHR, 2) hybrid_fwd(Args args) {
    extern __shared__ __attribute__((aligned(16))) unsigned char smem[];
    cg::grid_group grid = cg::this_grid();
    for (int ph = args.ph_lo; ph < args.ph_hi; ++ph) {
        int tid = threadIdx.x, g = blockIdx.x, G = gridDim.x;
        asm volatile("" : "+v"(tid)); asm volatile("" : "+s"(g)); asm volatile("" : "+s"(G));
        LAS unsigned char* lds = (LAS unsigned char*)smem;
        Ptrs P; P.x = args.in[0]; P.norm_gain = args.in[1]; P.w_in = args.in[2]; P.qg = args.in[3]; P.kg = args.in[4]; P.og = args.in[5]; P.wa = args.in[6]; P.ba = args.in[7]; P.gg = args.in[8]; P.w_out = args.in[9];
        P.out = args.out; P.ws = args.ws;
        asm volatile("" : "+s"(P.ws)); asm volatile("" : "+s"(P.out));
        const int layer = ph / PH_PER_LAYER, k = ph % PH_PER_LAYER;
        const float* xin = layer == 0 ? P.x : P.out;
        if (k == 0) {
            if (layer == 0) phase_weights(P, lds, G, tid, g);
            phase_rownorm(P, xin, layer, G, tid, g);
        } else if (k == 1) {
            pg8::Gemm gm{(const bf16*)(P.ws + WS_XN), (const bf16*)(P.ws + WS_WIN + layer * WIN_L), M, NP, DM}; pg8::StaticOrder S; S.init(M, NP, G, g);
            pg8::EpiBf16 E{(bf16*)(P.ws + WS_PROJ), NP};
            pg8::gemm_phase<pg8::EpiBf16, pg8::StaticOrder, true, true>(lds, gm, S, E, tid);
        } else if (DBG_SKIP_MIX && k >= 2 && k <= 4) {
        } else if (k == 2) {
            if (!DBG_SKIP_GLA && !DBG_RAW && !DBG_NO_LOCAL) for (int u = g; u < 1024; u += G) gla_local_unit(P, lds, layer, u, tid);
            if (!DBG_SKIP_ATTN) for (int u = g; u < 256; u += G) attn_unit(P, lds, layer, u, tid);
        } else if (k == 3) {
            if (!DBG_SKIP_GLA && !DBG_NO_INTER) for (int idx = g * NTHR + tid; idx < 65536; idx += G * NTHR) gla_scan(P, idx);
            if (!DBG_SKIP_ATTN) for (int u = 256 + g; u < 768; u += G) attn_unit(P, lds, layer, u, tid);
        } else if (k == 4) {
            if (!DBG_SKIP_GLA) for (int u = g; u < 1024; u += G) gla_out_unit(P, lds, layer, u, tid);
            if (!DBG_SKIP_ATTN) for (int u = 768 + g; u < 1024; u += G) attn_unit(P, lds, layer, u, tid);
        } else {
            pg8::Gemm gm{(const bf16*)(P.ws + WS_XN), (const bf16*)(P.ws + WS_WOUT + layer * WOUT_L), M, DM, DM}; pg8::StaticOrder S; S.init(M, DM, G, g);
            pg8::EpiRes E{xin, P.out, DM};
            pg8::gemm_phase<pg8::EpiRes, pg8::StaticOrder, true, true>(lds, gm, S, E, tid);
        }
        if (ph + 1 < args.ph_hi) grid_barrier(grid);
    }
}

extern "C" void kernel_launch(void* const* d_in, const int* in_sizes, int n_in, void* d_out, int out_size, void* d_ws, size_t ws_size, hipStream_t stream) {
    static int grid = 0;
    if (grid == 0) {
        if (n_in != 10 || out_size != M * DM || ws_size < WS_END) { fprintf(stderr, "kernel_launch: unexpected shapes (n_in %d out %d ws %zu)\n", n_in, out_size, ws_size); grid = -1; return; }
        int dev = 0, cus = 0, per_cu = 0;
        if (hipGetDevice(&dev) != hipSuccess || hipDeviceGetAttribute(&cus, hipDeviceAttributeMultiprocessorCount, dev) != hipSuccess) { grid = -1; return; }
        if (hipFuncSetAttribute((const void*)hybrid_fwd, hipFuncAttributeMaxDynamicSharedMemorySize, LDS_BYTES) != hipSuccess) { fprintf(stderr, "kernel_launch: hipFuncSetAttribute failed\n"); grid = -1; return; }
        if (hipOccupancyMaxActiveBlocksPerMultiprocessor(&per_cu, (const void*)hybrid_fwd, NTHR, LDS_BYTES) != hipSuccess || per_cu < 1) { fprintf(stderr, "kernel_launch: occupancy query says %d\n", per_cu); per_cu = 1; }
        (void)hipGetLastError();
        grid = cus;
    }
    if (grid < 0) return;
    Args a{};
    for (int i = 0; i < 10; ++i) a.in[i] = (const float*)d_in[i];
    a.out = (float*)d_out; a.ws = (unsigned char*)d_ws; a.ph_lo = 0; a.ph_hi = N_PHASES;
#if MK_PER_PHASE
    for (int ph = 0; ph < N_PHASES; ++ph) { a.ph_lo = ph; a.ph_hi = ph + 1; hipLaunchKernelGGL(hybrid_fwd, dim3(grid), dim3(NTHR), LDS_BYTES, stream, a); }
#else
    void* kargs[] = {&a};
    hipError_t e = hipLaunchCooperativeKernel((const void*)hybrid_fwd, dim3(grid), dim3(NTHR), kargs, LDS_BYTES, stream);
    if (e != hipSuccess) fprintf(stderr, "cooperative launch failed: %s (grid %d)\n", hipGetErrorString(e), grid);
#endif
}
```

```cpp
#include <hip/hip_runtime.h>
#include <hip/hip_cooperative_groups.h>
#include <cstdio>
#include <cstdint>
namespace cg = cooperative_groups;
#ifndef MK_PER_PHASE
#define MK_PER_PHASE 0
#endif

namespace pg8 {
#define PG8_LAS __attribute__((address_space(3)))
typedef unsigned short bf16_t;
typedef short bf16x8 __attribute__((ext_vector_type(8)));
typedef float f32x4 __attribute__((ext_vector_type(4)));
typedef unsigned u32x4 __attribute__((ext_vector_type(4)));
constexpr int BM = 256, BK = 64, HALF = 128, HTB = HALF * BK * 2, STAGE_BYTES = 8 * HTB, NXCD = 8, WGM = 4;

__host__ __device__ __forceinline__ int lds_byte(int r, int c) { const int st = (r >> 4) * 2 + (c >> 5), rr = r & 15, cc = c & 31, ob = rr * 64 + cc * 2; return st * 1024 + (ob ^ (((ob >> 9) & 1) << 5)); }
__host__ __device__ __forceinline__ void stage_rc(int b, int& R, int& C) { const int st = b / 1024, sb = b % 1024, swz = sb ^ (((sb >> 9) & 1) << 5); R = (st >> 1) * 16 + swz / 64; C = (st & 1) * 32 + (swz % 64) / 2; }
__host__ __device__ __forceinline__ int perm32(int rho) { const int n = rho >> 4, i = rho & 15; return 8 * (i >> 2) + 4 * n + (i & 3); }

struct Unit { int pm, pn; };
struct Gemm { const bf16_t* A; const bf16_t* Bt; int M, N, K; };

struct StaticOrder {
    int nM, nN, nwg, G, c;
    __host__ __device__ void init(int M, int N, int G_, int c_) { nM = M / BM; nN = N / BM; nwg = nM * nN; G = G_; c = c_; }
    __host__ __device__ bool next(int i, Unit& u) const {
        const long L = (long)i * G + c; if (L >= nwg) return false;
        int wgid = (int)L; { const int q = nwg / NXCD, r = nwg % NXCD, xcd = wgid % NXCD, off = wgid / NXCD; wgid = (xcd < r ? xcd * (q + 1) : r * (q + 1) + (xcd - r) * q) + off; }
        const int nig = WGM * nN, gid = wgid / nig, fm = gid * WGM, gsz = (nM - fm) < WGM ? (nM - fm) : WGM;
        u.pm = fm + ((wgid % nig) % gsz); u.pn = (wgid % nig) / gsz; return true;
    }
    __device__ __forceinline__ void a_ready(const Unit&) const {}
    __device__ __forceinline__ void done(const Unit&) const {}
};

typedef float f32x2_t __attribute__((ext_vector_type(2)));
typedef __bf16 bf16x2_t __attribute__((ext_vector_type(2)));
__device__ __forceinline__ unsigned cvt_pk_bf16(float lo, float hi) { f32x2_t v = {lo, hi}; bf16x2_t b = __builtin_convertvector(v, bf16x2_t); return __builtin_bit_cast(unsigned, b); }

struct EpiBf16 {
    static constexpr bool PERM = true, AFTER_DRAIN = false;
    bf16_t* O; int ldc;
    __device__ __forceinline__ void operator()(const f32x4 (&acc)[2][2][4][2], const Unit& u, int wr, int wc, int fr, int fq) const {
        const int row0 = u.pm * BM + wr * 64 + fr; const int col0 = u.pn * BM + wc * 32 + 8 * fq;
#pragma unroll
        for (int ai = 0; ai < 2; ++ai)
#pragma unroll
            for (int m = 0; m < 4; ++m) { bf16_t* rowp = O + (size_t)(row0 + ai * HALF + m * 16) * ldc + col0;
#pragma unroll
                for (int bj = 0; bj < 2; ++bj) { const f32x4 v0 = acc[ai][bj][m][0], v1 = acc[ai][bj][m][1];
                    u32x4 w; w.x = cvt_pk_bf16(v0[0], v0[1]); w.y = cvt_pk_bf16(v0[2], v0[3]); w.z = cvt_pk_bf16(v1[0], v1[1]); w.w = cvt_pk_bf16(v1[2], v1[3]);
                    *(u32x4*)(rowp + bj * HALF) = w; } }
    }
};
struct EpiRes {
    static constexpr bool PERM = false, AFTER_DRAIN = false;
    const float* base; float* out; int ldc; int last;
    __device__ __forceinline__ void operator()(const f32x4 (&acc)[2][2][4][2], const Unit& u, int wr, int wc, int fr, int fq) const {
        const int row0 = u.pm * BM + wr * 64 + fr; const int col0 = u.pn * BM + wc * 32 + 4 * fq;
#pragma unroll
        for (int ai = 0; ai < 2; ++ai)
#pragma unroll
            for (int mp = 0; mp < 2; ++mp) {
                f32x4 b[2][2][2];
#pragma unroll
                for (int mm = 0; mm < 2; ++mm) { const size_t off = (size_t)(row0 + ai * HALF + (2 * mp + mm) * 16) * ldc + col0;
#pragma unroll
                    for (int bj = 0; bj < 2; ++bj)
#pragma unroll
                        for (int n = 0; n < 2; ++n) b[mm][bj][n] = *(const f32x4*)(base + off + bj * HALF + n * 16); }
                asm volatile("" ::: "memory");
#pragma unroll
                for (int mm = 0; mm < 2; ++mm) { const size_t off = (size_t)(row0 + ai * HALF + (2 * mp + mm) * 16) * ldc + col0;
#pragma unroll
                    for (int bj = 0; bj < 2; ++bj)
#pragma unroll
                        for (int n = 0; n < 2; ++n) { const f32x4 o = b[mm][bj][n] + acc[ai][bj][2 * mp + mm][n]; f32x4* dst = (f32x4*)(out + off + bj * HALF + n * 16); if (last) __builtin_nontemporal_store(o, dst); else *dst = o; } }
                asm volatile("" ::: "memory");
            }
    }
};

template <class Epi, class Sched, bool ALIGN_EPI = false, bool SP2 = false>
__device__ __forceinline__ void gemm_phase(PG8_LAS unsigned char* lds, const Gemm g, const Sched& S, const Epi& E, const int tid) {
    const int wid = __builtin_amdgcn_readfirstlane(tid >> 6), lane = tid & 63, wr = wid >> 2, wc = wid & 3, fr = lane & 15, fq = lane >> 4;
    const int K = g.K, nt = K / BK;
    unsigned voffA[2], voffB[2];
#pragma unroll
    for (int i = 0; i < 2; ++i) { int R, C; stage_rc(tid * 16 + i * 8192, R, C); const int Rb = Epi::PERM ? ((R & ~31) + perm32(R & 31)) : R;
        voffA[i] = (unsigned)(R * K + C) * 2u; voffB[i] = (unsigned)(Rb * K + C) * 2u; }
    const size_t kstep = (size_t)(BK * 2);
    const size_t hstep = (size_t)HALF * K * 2;
    const size_t tstep = 2 * hstep;
    const unsigned ldsw = (unsigned)wid * 1024u;
    const int aoff = lds_byte(wr * 64 + fr, fq * 8), boff = lds_byte(wc * 32 + fr, fq * 8);
#define PG8_SA(b, h) (((b) * 2 + (h)) * HTB)
#define PG8_SB(b, h) ((4 + (b) * 2 + (h)) * HTB)
#define PG8_STAGE(bufoff, gbase, voff) do { _Pragma("unroll") for (int _i = 0; _i < 2; ++_i) \
        __builtin_amdgcn_global_load_lds((const unsigned*)((const char*)(gbase) + (voff)[_i]), (PG8_LAS unsigned*)(lds + (bufoff) + ldsw + _i * 8192), 16, 0, 0); } while (0)
#define PG8_LDA(dst, b, h) do { _Pragma("unroll") for (int m = 0; m < 4; ++m) _Pragma("unroll") for (int k = 0; k < 2; ++k) dst[m][k] = *(const PG8_LAS bf16x8*)(lds + PG8_SA(b, h) + aoff + m * 2048 + k * 1024); } while (0)
#define PG8_LDB(dst, b, h) do { _Pragma("unroll") for (int n = 0; n < 2; ++n) _Pragma("unroll") for (int k = 0; k < 2; ++k) dst[n][k] = *(const PG8_LAS bf16x8*)(lds + PG8_SB(b, h) + boff + n * 2048 + k * 1024); } while (0)
#define PG8_MMA(ai, bj, At, Bt) do { __builtin_amdgcn_s_setprio(1); _Pragma("unroll") for (int m = 0; m < 4; ++m) _Pragma("unroll") for (int n = 0; n < 2; ++n) _Pragma("unroll") for (int k = 0; k < 2; ++k) \
        acc[ai][bj][m][n] = __builtin_amdgcn_mfma_f32_16x16x32_bf16(Bt[n][k], At[m][k], acc[ai][bj][m][n], 0, 0, 0); __builtin_amdgcn_s_setprio(0); } while (0)
#define PG8_WAIT_V(n) asm volatile("s_waitcnt vmcnt(" #n ")" ::: "memory")
#define PG8_WAIT_L(n) asm volatile("s_waitcnt lgkmcnt(" #n ")" ::: "memory")
#define PG8_BAR __builtin_amdgcn_s_barrier()
#define PG8_SCHED __builtin_amdgcn_sched_barrier(0)
    Unit cur, nxt; int ui = 0;
    if (!S.next(0, cur)) return;
    f32x4 acc[2][2][4][2];
#pragma unroll
    for (int a = 0; a < 2; ++a)
#pragma unroll
        for (int b = 0; b < 2; ++b)
#pragma unroll
            for (int m = 0; m < 4; ++m)
#pragma unroll
                for (int n = 0; n < 2; ++n) acc[a][b][m][n] = (f32x4){0.f, 0.f, 0.f, 0.f};
    bf16x8 At[4][2], B0[2][2], B1[2][2];
    const char* cA = (const char*)g.A + (size_t)cur.pm * tstep; const char* cB = (const char*)g.Bt + (size_t)cur.pn * tstep;
    S.a_ready(cur);
    if constexpr (SP2) {
        PG8_STAGE(PG8_SB(0, 0), cB, voffB); PG8_STAGE(PG8_SB(0, 1), cB + hstep, voffB); PG8_STAGE(PG8_SA(0, 0), cA, voffA); PG8_STAGE(PG8_SA(0, 1), cA + hstep, voffA);
        if (wr == 1) PG8_BAR;
        PG8_WAIT_V(2); PG8_BAR;
        PG8_STAGE(PG8_SB(1, 0), cB + kstep, voffB); PG8_STAGE(PG8_SA(1, 0), cA + kstep, voffA); PG8_STAGE(PG8_SB(1, 1), cB + hstep + kstep, voffB);
        PG8_WAIT_V(6); PG8_BAR;
    } else {
        PG8_STAGE(PG8_SB(0, 0), cB, voffB); PG8_STAGE(PG8_SA(0, 0), cA, voffA); PG8_STAGE(PG8_SB(0, 1), cB + hstep, voffB); PG8_STAGE(PG8_SA(0, 1), cA + hstep, voffA);
        if (wr == 1) PG8_BAR;
        PG8_WAIT_V(4); PG8_BAR;
        PG8_STAGE(PG8_SB(1, 0), cB + kstep, voffB); PG8_STAGE(PG8_SA(1, 0), cA + kstep, voffA); PG8_STAGE(PG8_SB(1, 1), cB + hstep + kstep, voffB);
        PG8_WAIT_V(6); PG8_BAR;
    }
    for (;;) {
        const bool has_next = S.next(ui + 1, nxt);
        const char* nA = has_next ? (const char*)g.A + (size_t)nxt.pm * tstep : cA; const char* nB = has_next ? (const char*)g.Bt + (size_t)nxt.pn * tstep : cB;
        for (int t = 0; t < nt; t += 2) {
            const bool last = (t == nt - 2);
            const char* a1 = cA + (size_t)(t + 1) * kstep;
            const char* a2 = last ? nA : cA + (size_t)(t + 2) * kstep; const char* b2 = last ? nB : cB + (size_t)(t + 2) * kstep;
            const char* a3 = a2 + kstep; const char* b3 = b2 + kstep;
            if (last && has_next) S.a_ready(nxt);
            if constexpr (SP2) {
            PG8_LDB(B0, 0, 0); PG8_LDB(B1, 0, 1); PG8_SCHED; PG8_LDA(At, 0, 0); PG8_STAGE(PG8_SA(1, 1), a1 + hstep, voffA);
            PG8_WAIT_V(8); PG8_WAIT_L(0); PG8_BAR; PG8_MMA(0, 0, At, B0); PG8_MMA(0, 1, At, B1); PG8_BAR; PG8_SCHED;
            PG8_LDA(At, 0, 1); PG8_STAGE(PG8_SB(0, 0), b2, voffB); PG8_STAGE(PG8_SB(0, 1), b2 + hstep, voffB); PG8_STAGE(PG8_SA(0, 0), a2, voffA);
            PG8_WAIT_V(8); PG8_WAIT_L(0); PG8_BAR; PG8_MMA(1, 0, At, B0); PG8_MMA(1, 1, At, B1); PG8_BAR; PG8_SCHED;
            PG8_LDB(B0, 1, 0); PG8_LDB(B1, 1, 1); PG8_SCHED; PG8_LDA(At, 1, 0); PG8_STAGE(PG8_SA(0, 1), a2 + hstep, voffA);
            PG8_WAIT_V(8); PG8_WAIT_L(0); PG8_BAR; PG8_MMA(0, 0, At, B0); PG8_MMA(0, 1, At, B1); PG8_BAR; PG8_SCHED;
            PG8_LDA(At, 1, 1); PG8_STAGE(PG8_SB(1, 0), b3, voffB); PG8_STAGE(PG8_SB(1, 1), b3 + hstep, voffB); PG8_STAGE(PG8_SA(1, 0), a3, voffA);
            PG8_WAIT_V(8); PG8_WAIT_L(0); PG8_BAR; PG8_MMA(1, 0, At, B0); PG8_MMA(1, 1, At, B1); PG8_BAR; PG8_SCHED;
            } else {
            PG8_LDB(B0, 0, 0); PG8_SCHED; PG8_LDA(At, 0, 0); PG8_STAGE(PG8_SA(1, 1), a1 + hstep, voffA);
            PG8_WAIT_L(8); PG8_BAR; PG8_WAIT_L(0); PG8_MMA(0, 0, At, B0); PG8_BAR; PG8_SCHED;
            PG8_LDB(B1, 0, 1); PG8_STAGE(PG8_SB(0, 0), b2, voffB);
            PG8_BAR; PG8_WAIT_L(0); PG8_MMA(0, 1, At, B1); PG8_BAR;
            PG8_LDA(At, 0, 1); PG8_STAGE(PG8_SA(0, 0), a2, voffA);
            PG8_BAR; PG8_WAIT_L(0); PG8_MMA(1, 0, At, B0); PG8_BAR; PG8_SCHED;
            PG8_STAGE(PG8_SB(0, 1), b2 + hstep, voffB);
            PG8_WAIT_V(6); PG8_BAR; PG8_MMA(1, 1, At, B1); PG8_BAR;
            PG8_LDB(B0, 1, 0); PG8_SCHED; PG8_LDA(At, 1, 0); PG8_STAGE(PG8_SA(0, 1), a2 + hstep, voffA);
            PG8_WAIT_L(8); PG8_BAR; PG8_WAIT_L(0); PG8_MMA(0, 0, At, B0); PG8_BAR; PG8_SCHED;
            PG8_LDB(B1, 1, 1); PG8_STAGE(PG8_SB(1, 0), b3, voffB);
            PG8_BAR; PG8_WAIT_L(0); PG8_MMA(0, 1, At, B1); PG8_BAR;
            PG8_LDA(At, 1, 1); PG8_STAGE(PG8_SA(1, 0), a3, voffA);
            PG8_BAR; PG8_WAIT_L(0); PG8_MMA(1, 0, At, B0); PG8_BAR; PG8_SCHED;
            PG8_STAGE(PG8_SB(1, 1), b3 + hstep, voffB);
            PG8_WAIT_V(6); PG8_BAR; PG8_MMA(1, 1, At, B1); PG8_BAR;
            }
        }
        if constexpr (ALIGN_EPI) { if (wr == 0) PG8_BAR; }
        if constexpr (!Epi::AFTER_DRAIN) { E(acc, cur, wr, wc, fr, fq); S.done(cur); }
        if (!has_next) break;
#pragma unroll
        for (int a = 0; a < 2; ++a)
#pragma unroll
            for (int b = 0; b < 2; ++b)
#pragma unroll
                for (int m = 0; m < 4; ++m)
#pragma unroll
                    for (int n = 0; n < 2; ++n) acc[a][b][m][n] = (f32x4){0.f, 0.f, 0.f, 0.f};
        cur = nxt; cA = nA; cB = nB; ++ui;
        if constexpr (ALIGN_EPI) { if (wr == 1) PG8_BAR; }
    }
    PG8_WAIT_V(0);
    if constexpr (!ALIGN_EPI) { if (wr == 0) PG8_BAR; }
    PG8_BAR;
#undef PG8_SA
#undef PG8_SB
#undef PG8_STAGE
#undef PG8_LDA
#undef PG8_LDB
#undef PG8_MMA
#undef PG8_WAIT_V
#undef PG8_WAIT_L
#undef PG8_BAR
#undef PG8_SCHED
}
}

#define LAS __attribute__((address_space(3)))
typedef unsigned short bf16;
typedef short bf16x8 __attribute__((ext_vector_type(8)));
typedef float f32x4 __attribute__((ext_vector_type(4)));
typedef unsigned u32x4 __attribute__((ext_vector_type(4)));
typedef unsigned u32x2 __attribute__((ext_vector_type(2)));

constexpr int NWAVES = 8, NTHR = 512;
constexpr int BATCH = 4, SEQ = 4096, DM = 2048, DEPTH = 2;
constexpr int M = BATCH * SEQ;
constexpr int INW = 7184;
constexpr int NP = 7168;
constexpr int C_SBQ = 0, C_SBK = 1024, C_SBV = 2048, C_SBG = 3072, C_GLQ = 4096, C_GLK = 4608, C_GLV = 5120, C_GLG = 6144;
constexpr float EPS = 1e-6f;
constexpr int NCHUNK = 64;
constexpr size_t MiB = 1u << 20;
constexpr size_t WS_WIN = 2 * MiB, WIN_L = (size_t)NP * DM * 2;
constexpr size_t WS_WOUT = 58 * MiB, WOUT_L = (size_t)DM * DM * 2;
constexpr size_t WS_PROJ = 74 * MiB;
constexpr size_t WS_XN = 298 * MiB;
constexpr size_t WS_MIX = 362 * MiB;
constexpr size_t WS_KV = 426 * MiB;
constexpr size_t WS_DN = 490 * MiB;
constexpr size_t WS_WLRT = 491 * MiB, WLRT_L = 16 * DM * 2;
constexpr size_t WS_END = 492 * MiB;
constexpr int LDS_BYTES = 147456;

__device__ __forceinline__ unsigned pk2(float lo, float hi) { return pg8::cvt_pk_bf16(lo, hi); }
__device__ __forceinline__ unsigned short f2bf(float f) { return (unsigned short)(pk2(f, 0.f) & 0xffffu); }
__device__ __forceinline__ float bf2f(unsigned short v) { return __uint_as_float((unsigned)v << 16); }
__device__ __forceinline__ float lo_f(unsigned w) { return __uint_as_float(w << 16); }
__device__ __forceinline__ float hi_f(unsigned w) { return __uint_as_float(w & 0xffff0000u); }
__device__ __forceinline__ float wave_sum(float v) {
#pragma unroll
    for (int o = 1; o < 64; o <<= 1) v += __shfl_xor(v, o);
    return v;
}
__device__ __forceinline__ float silu(float g) { return g / (1.f + __expf(-g)); }
__device__ __forceinline__ float softplus(float z) { return fmaxf(z, 0.f) + __logf(1.f + __expf(-fabsf(z))); }
#define LDS_WAIT() asm volatile("s_waitcnt lgkmcnt(0)" ::: "memory")
#define MFMA16(a, b, c) __builtin_amdgcn_mfma_f32_16x16x32_bf16((a), (b), (c), 0, 0, 0)

struct Ptrs {
    const float* x; const float* norm_gain; const float* w_in; const float* qg; const float* kg; const float* og; const float* wa; const float* ba; const float* gg; const float* w_out;
    float* out; unsigned char* ws;
};

__device__ __forceinline__ void transpose_item(const float* W, int ldw, int nblk, int K, bf16* WT, LAS float* scr, int item, int lane) {
    const int kb = item / nblk, nb = item % nblk, k0 = 64 * kb, n0 = 32 * nb;
#pragma unroll 8
    for (int i = 0; i < 32; ++i) { const int kk = 2 * i + (lane >> 5); scr[kk * 33 + (lane & 31)] = __builtin_nontemporal_load(W + (size_t)(k0 + kk) * ldw + n0 + (lane & 31)); }
    LDS_WAIT(); asm volatile("" ::: "memory");
    const int c = lane & 7;
#pragma unroll
    for (int j = 0; j < 4; ++j) { const int n = (lane >> 3) + 8 * j; const LAS float* s = scr + (8 * c) * 33 + n;
        u32x4 o; o.x = pk2(s[0 * 33], s[1 * 33]); o.y = pk2(s[2 * 33], s[3 * 33]); o.z = pk2(s[4 * 33], s[5 * 33]); o.w = pk2(s[6 * 33], s[7 * 33]);
        *(u32x4*)(WT + (size_t)(n0 + n) * K + k0 + 8 * c) = o; }
    LDS_WAIT(); asm volatile("" ::: "memory");
}

__device__ __forceinline__ void phase_weights(const Ptrs& P, LAS unsigned char* lds, int G, const int tid, const int bid) {
    const int lane = tid & 63, wave = tid >> 6;
    LAS float* scr = (LAS float*)(lds + wave * 16384);
    const int gw = bid * NWAVES + wave, NGW = G * NWAVES;
    constexpr int I_IN = (DM / 64) * (7168 / 32), I_OUT = (DM / 64) * (DM / 32);
    for (int it = gw; it < DEPTH * (I_IN + I_OUT); it += NGW) {
        const int l = it / (I_IN + I_OUT); int r = it % (I_IN + I_OUT);
        if (r < I_IN) transpose_item(P.w_in + (size_t)l * DM * INW, INW, 7168 / 32, DM, (bf16*)(P.ws + WS_WIN + l * WIN_L), scr, r, lane);
        else transpose_item(P.w_out + (size_t)l * DM * DM, DM, DM / 32, DM, (bf16*)(P.ws + WS_WOUT + l * WOUT_L), scr, r - I_IN, lane);
    }
    for (int it = bid * NTHR + tid; it < DEPTH * 16 * DM; it += G * NTHR) {
        const int l = it / (16 * DM), r = (it / DM) & 15, d = it % DM;
        ((bf16*)(P.ws + WS_WLRT + l * WLRT_L))[r * DM + d] = f2bf(P.w_in[(size_t)l * DM * INW + (size_t)d * INW + 7168 + r]);
    }
}

__device__ __forceinline__ void phase_rownorm(const Ptrs& P, const float* xin, int layer, int G, const int tid, const int bid) {
    const int lane = tid & 63, wave = tid >> 6;
    const int gw = bid * NWAVES + wave, NGW = G * NWAVES;
    const f32x4* gp = (const f32x4*)(P.norm_gain + layer * DM) + lane;
    bf16* XN = (bf16*)(P.ws + WS_XN);
    for (int m = gw; m < M; m += NGW) {
        const f32x4* xr = (const f32x4*)(xin + (size_t)m * DM) + lane;
        f32x4 v[8]; float s = 0.f;
#pragma unroll
        for (int j = 0; j < 8; ++j) { v[j] = __builtin_nontemporal_load(xr + 64 * j); s += (v[j][0] * v[j][0] + v[j][1] * v[j][1]) + (v[j][2] * v[j][2] + v[j][3] * v[j][3]); }
        const float rs = rsqrtf(wave_sum(s) * (1.f / DM) + EPS);
        u32x2* o8 = (u32x2*)(XN + (size_t)m * DM) + lane;
#pragma unroll
        for (int j = 0; j < 8; ++j) { const f32x4 g = gp[64 * j]; u32x2 w; w.x = pk2(v[j][0] * rs * g[0], v[j][1] * rs * g[1]); w.y = pk2(v[j][2] * rs * g[2], v[j][3] * rs * g[3]); o8[64 * j] = w; }
    }
}

constexpr int AQ_LD = 136, AV_LD = 72;
constexpr int A_KS = 0, A_KS_SZ = 64 * AQ_LD * 2, A_VT = A_KS + 2 * A_KS_SZ, A_VT_SZ = 128 * AV_LD * 2, A_FLAG = A_VT + 2 * A_VT_SZ, A_END = A_FLAG + 64;
static_assert(A_END <= 131072, "attention LDS");

template <bool MASK>
__device__ __forceinline__ void sb_scan(const f32x4 (&z)[4], int kb, int tq, int fq, float& R, float (&p)[4][4]) {
    float be[4][4], nb[4][4], tl[4], up[4], T[4];
#pragma unroll
    for (int n = 0; n < 4; ++n) { float t = 1.f;
#pragma unroll
        for (int i = 0; i < 4; ++i) { const float z2 = fminf(fmaxf(z[n][i], -100.f), 100.f); const float e = __builtin_amdgcn_exp2f(-z2); const float r = __builtin_amdgcn_rcpf(1.f + e);
            float bb = r, qq = e * r;
            if (MASK) { const bool valid = (kb + 16 * n + i) < tq; bb = valid ? bb : 0.f; qq = valid ? qq : 1.f; }
            be[n][i] = bb; nb[n][i] = qq; t *= qq; }
        tl[n] = t; }
#pragma unroll
    for (int n = 0; n < 4; ++n) { const float a = __shfl_xor(tl[n], 16), bq = __shfl_xor(tl[n], 32), c = __shfl_xor(tl[n], 48);
        up[n] = ((fq & 1) ? 1.f : a) * ((fq & 2) ? 1.f : (bq * c)); T[n] = (tl[n] * a) * (bq * c); }
    float base = R;
#pragma unroll
    for (int n = 3; n >= 0; --n) { float run = base * up[n];
#pragma unroll
        for (int i = 3; i >= 0; --i) { p[n][i] = be[n][i] * run; run *= nb[n][i]; }
        base *= T[n]; }
    R = base;
}

__device__ __forceinline__ void attn_unit(const Ptrs& P, LAS unsigned char* lds, int layer, int u, const int tid) {
    const int lane = tid & 63, w = __builtin_amdgcn_readfirstlane(tid >> 6), fr = lane & 15, fq = lane >> 4;
    const int bh = u >> 5, qb = u & 31, b = bh >> 3, h = bh & 7;
    const int t0 = qb * 128, rowbase = b * SEQ;
    const bf16* PR = (const bf16*)(P.ws + WS_PROJ);
    bf16* MIX = (bf16*)(P.ws + WS_MIX);
    const int kr = tid >> 3, kpart = tid & 7;
    const size_t kvoff = (size_t)rowbase * NP + h * 128 + kpart * 16;
    const size_t vvoff = (size_t)(rowbase + lane) * NP + C_SBV + h * 128 + 16 * w;
    u32x4 k0, k1, v0, v1;
#define ATT_ISSUE(kt_) do { const bf16* rp_ = PR + kvoff + (size_t)((kt_) * 64 + kr) * NP; k0 = ((const u32x4*)(rp_ + C_SBK))[0]; k1 = ((const u32x4*)(rp_ + C_SBK))[1]; \
                            const bf16* vp_ = PR + vvoff + (size_t)((kt_) * 64) * NP; v0 = ((const u32x4*)vp_)[0]; v1 = ((const u32x4*)vp_)[1]; } while (0)
    ATT_ISSUE(2 * qb + 1);
    const int tq = t0 + 16 * w + fr;
    bf16x8 qf[4];
    {
        const u32x4* src = (const u32x4*)(PR + (size_t)(rowbase + tq) * NP + C_SBQ + h * 128 + fq * 8);
        u32x4 wv[4]; float ss = 0.f;
#pragma unroll
        for (int ks = 0; ks < 4; ++ks) wv[ks] = src[ks * 4];
#pragma unroll
        for (int ks = 0; ks < 4; ++ks)
#pragma unroll
            for (int e = 0; e < 4; ++e) { const float a = lo_f(wv[ks][e]), c = hi_f(wv[ks][e]); ss += a * a + c * c; }
        ss += __shfl_xor(ss, 16); ss += __shfl_xor(ss, 32);
        const float rs = rsqrtf(ss * (1.f / 128.f) + EPS) * (0.08838834764831845f * 1.4426950408889634f);
#pragma unroll
        for (int ks = 0; ks < 4; ++ks) { const float* g = P.qg + layer * 128 + ks * 32 + fq * 8; u32x4 o;
#pragma unroll
            for (int e = 0; e < 4; ++e) o[e] = pk2(lo_f(wv[ks][e]) * rs * g[2 * e], hi_f(wv[ks][e]) * rs * g[2 * e + 1]);
            qf[ks] = __builtin_bit_cast(bf16x8, o); }
    }
    f32x4 oacc[8];
#pragma unroll
    for (int n = 0; n < 8; ++n) oacc[n] = (f32x4){0.f, 0.f, 0.f, 0.f};
    float R = 1.f;
    int done = 0, cur = 0;
    float kgain[16];
#pragma unroll
    for (int j = 0; j < 16; ++j) kgain[j] = P.kg[layer * 128 + kpart * 16 + j];
    __syncthreads();
    for (int kt = 2 * qb + 1; kt >= 0; --kt) {
        LAS bf16* Ks = (LAS bf16*)(lds + A_KS + cur * A_KS_SZ); LAS bf16* Vt = (LAS bf16*)(lds + A_VT + cur * A_VT_SZ);
        {
            float kv[16]; float ss = 0.f;
#pragma unroll
            for (int e = 0; e < 4; ++e) { kv[2 * e] = lo_f(k0[e]); kv[2 * e + 1] = hi_f(k0[e]); kv[8 + 2 * e] = lo_f(k1[e]); kv[8 + 2 * e + 1] = hi_f(k1[e]); }
#pragma unroll
            for (int j = 0; j < 16; ++j) ss += kv[j] * kv[j];
            ss += __shfl_xor(ss, 1); ss += __shfl_xor(ss, 2); ss += __shfl_xor(ss, 4);
            const float rs = rsqrtf(ss * (1.f / 128.f) + EPS);
            u32x4 o0, o1;
#pragma unroll
            for (int e = 0; e < 4; ++e) { o0[e] = pk2(kv[2 * e] * rs * kgain[2 * e], kv[2 * e + 1] * rs * kgain[2 * e + 1]); o1[e] = pk2(kv[8 + 2 * e] * rs * kgain[8 + 2 * e], kv[8 + 2 * e + 1] * rs * kgain[8 + 2 * e + 1]); }
            *(LAS u32x4*)(Ks + kr * AQ_LD + kpart * 16) = o0; *(LAS u32x4*)(Ks + kr * AQ_LD + kpart * 16 + 8) = o1;
#pragma unroll
            for (int e = 0; e < 4; ++e) {
                Vt[(16 * w + 2 * e) * AV_LD + lane] = (bf16)(v0[e] & 0xffffu); Vt[(16 * w + 2 * e + 1) * AV_LD + lane] = (bf16)(v0[e] >> 16);
                Vt[(16 * w + 8 + 2 * e) * AV_LD + lane] = (bf16)(v1[e] & 0xffffu); Vt[(16 * w + 8 + 2 * e + 1) * AV_LD + lane] = (bf16)(v1[e] >> 16); }
        }
        if (kt > 0) ATT_ISSUE(kt - 1);
        const bool wall = __builtin_amdgcn_ballot_w64(done != 0) == ~0ull;
        {
            LAS unsigned* fl = (LAS unsigned*)(lds + A_FLAG) + cur * 8;
            if (lane == 0) fl[w] = wall ? 1u : 0u;
            __syncthreads();
            const u32x4 fa = *(const LAS u32x4*)fl, fb = *(const LAS u32x4*)(fl + 4);
            if ((fa.x & fa.y & fa.z & fa.w & fb.x & fb.y & fb.z & fb.w) != 0u) break;
        }
        if (!wall && kt * 64 < t0 + 16 * w + 16) {
        f32x4 z[4];
#pragma unroll
        for (int n = 0; n < 4; ++n) z[n] = (f32x4){0.f, 0.f, 0.f, 0.f};
#pragma unroll
        for (int ks = 0; ks < 4; ++ks)
#pragma unroll
            for (int n = 0; n < 4; ++n) { const bf16x8 ka = *(const LAS bf16x8*)(Ks + (16 * n + fr) * AQ_LD + ks * 32 + fq * 8); z[n] = MFMA16(ka, qf[ks], z[n]); }
        float p[4][4];
        if (kt >= 2 * qb) sb_scan<true>(z, kt * 64 + 4 * fq, tq, fq, R, p); else sb_scan<false>(z, kt * 64 + 4 * fq, tq, fq, R, p);
        done = (R == 0.f);
#pragma unroll
        for (int s2 = 0; s2 < 2; ++s2) { u32x4 pw; pw.x = pk2(p[2 * s2][0], p[2 * s2][1]); pw.y = pk2(p[2 * s2][2], p[2 * s2][3]); pw.z = pk2(p[2 * s2 + 1][0], p[2 * s2 + 1][1]); pw.w = pk2(p[2 * s2 + 1][2], p[2 * s2 + 1][3]);
            const bf16x8 pb = __builtin_bit_cast(bf16x8, pw);
#pragma unroll
            for (int m = 0; m < 8; ++m) { const LAS bf16* vr = Vt + (16 * m + fr) * AV_LD + 32 * s2 + 4 * fq;
                u32x4 vw; const u32x2 lo = *(const LAS u32x2*)vr, hi = *(const LAS u32x2*)(vr + 16); vw.x = lo.x; vw.y = lo.y; vw.z = hi.x; vw.w = hi.y;
                oacc[m] = MFMA16(__builtin_bit_cast(bf16x8, vw), pb, oacc[m]); } }
        }
        cur ^= 1;
    }
#undef ATT_ISSUE
    {
        const size_t m = (size_t)(rowbase + tq);
        u32x2 gv[8];
#pragma unroll
        for (int n = 0; n < 8; ++n) gv[n] = *(const u32x2*)(PR + m * NP + C_SBG + h * 128 + 16 * n + 4 * fq);
        f32x4 gnv[8];
#pragma unroll
        for (int n = 0; n < 8; ++n) gnv[n] = *(const f32x4*)(P.og + layer * 1024 + h * 128 + 16 * n + 4 * fq);
        float ss = 0.f;
#pragma unroll
        for (int n = 0; n < 8; ++n) ss += (oacc[n][0] * oacc[n][0] + oacc[n][1] * oacc[n][1]) + (oacc[n][2] * oacc[n][2] + oacc[n][3] * oacc[n][3]);
        ss += __shfl_xor(ss, 16); ss += __shfl_xor(ss, 32);
        const float rs = rsqrtf(ss * (1.f / 128.f) + EPS);
#pragma unroll
        for (int n = 0; n < 8; ++n) { const int d = h * 128 + 16 * n + 4 * fq; const f32x4 gn = gnv[n];
            u32x2 o; o.x = pk2(oacc[n][0] * rs * gn[0] * silu(lo_f(gv[n].x)), oacc[n][1] * rs * gn[1] * silu(hi_f(gv[n].x)));
            o.y = pk2(oacc[n][2] * rs * gn[2] * silu(lo_f(gv[n].y)), oacc[n][3] * rs * gn[3] * silu(hi_f(gv[n].y)));
            *(u32x2*)(MIX + m * DM + d) = o; }
    }
}

constexpr int G_LRS = 137216, G_LRP = 0;
__device__ __forceinline__ void gla_lowrank(const Ptrs& P, LAS unsigned char* lds, int layer, size_t m0, const int tid) {
    const int lane = tid & 63, w = __builtin_amdgcn_readfirstlane(tid >> 6), fr = lane & 15, fq = lane >> 4;
    const bf16* XN = (const bf16*)(P.ws + WS_XN); const bf16* WL = (const bf16*)(P.ws + WS_WLRT + layer * WLRT_L);
    LAS float* LRP = (LAS float*)(lds + G_LRP); LAS float* LRS = (LAS float*)(lds + G_LRS);
    __syncthreads();
    f32x4 acc[4];
#pragma unroll
    for (int rt = 0; rt < 4; ++rt) acc[rt] = (f32x4){0.f, 0.f, 0.f, 0.f};
#pragma unroll
    for (int kh = 0; kh < 2; ++kh) {
        bf16x8 bf[4], af[4][4];
#pragma unroll
        for (int k4 = 0; k4 < 4; ++k4) { const int kk = 256 * w + (4 * kh + k4) * 32 + fq * 8; bf[k4] = *(const bf16x8*)(WL + fr * DM + kk);
#pragma unroll
            for (int rt = 0; rt < 4; ++rt) af[k4][rt] = *(const bf16x8*)(XN + (m0 + 16 * rt + fr) * DM + kk); }
#pragma unroll
        for (int k4 = 0; k4 < 4; ++k4)
#pragma unroll
            for (int rt = 0; rt < 4; ++rt) acc[rt] = MFMA16(af[k4][rt], bf[k4], acc[rt]);
    }
#pragma unroll
    for (int rt = 0; rt < 4; ++rt)
#pragma unroll
        for (int i = 0; i < 4; ++i) LRP[(w * 64 + 16 * rt + 4 * fq + i) * 16 + fr] = acc[rt][i];
    __syncthreads();
#pragma unroll
    for (int e = 0; e < 2; ++e) { const int o = tid + 512 * e; float sum = 0.f;
#pragma unroll
        for (int ww = 0; ww < 8; ++ww) sum += LRP[ww * 1024 + o];
        LRS[o] = sum; }
    __syncthreads();
}

constexpr int G_CUM = 0, G_PS = 126976, G_QD = 64 * 132 * 4, G_KI = G_QD + 64 * 136 * 2, G_KDT = G_KI + 64 * 136 * 2, G_VT = G_KDT + 128 * 72 * 2, G_TOT = G_VT + 256 * 72 * 2, G_END = G_TOT + 4 * 128 * 4;
static_assert(G_END <= G_PS && G_PS + 64 * 72 * 2 <= LDS_BYTES, "gla LDS");

__device__ __forceinline__ void gla_local_unit(const Ptrs& P, LAS unsigned char* lds, int layer, int u, const int tid, const u32x4 bw, const float bias) {
    const int lane = tid & 63, w = __builtin_amdgcn_readfirstlane(tid >> 6), fr = lane & 15, fq = lane >> 4;
    const int bh = u >> 6, n = u & 63, b = bh >> 2, h = bh & 3;
    const size_t m0 = (size_t)b * SEQ + n * 64;
    bf16* PR = (bf16*)(P.ws + WS_PROJ);
    bf16* KVT = (bf16*)(P.ws + WS_KV) + (size_t)u * 32768;
    float* DN = (float*)(P.ws + WS_DN) + (size_t)u * 128;
    LAS float* CUM = (LAS float*)(lds + G_CUM); LAS bf16* Ps = (LAS bf16*)(lds + G_PS); LAS bf16* Qd = (LAS bf16*)(lds + G_QD); LAS bf16* Ki = (LAS bf16*)(lds + G_KI);
    LAS bf16* KdT = (LAS bf16*)(lds + G_KDT); LAS bf16* VT = (LAS bf16*)(lds + G_VT); LAS float* TOT = (LAS float*)(lds + G_TOT);
    __syncthreads();
    const int t = lane, c0 = 16 * w, dv0 = 32 * w;
    bf16* qp = PR + (m0 + t) * NP + C_GLQ + h * 128 + c0; const bf16* kp = PR + (m0 + t) * NP + C_GLK + h * 128 + c0;
    const u32x4 q0 = ((const u32x4*)qp)[0], q1 = ((const u32x4*)qp)[1], k0 = ((const u32x4*)kp)[0], k1 = ((const u32x4*)kp)[1];
    u32x4 vv[4];
    {   const u32x4* vp = (const u32x4*)(PR + (m0 + t) * NP + C_GLV + h * 256 + dv0);
#pragma unroll
        for (int j = 0; j < 4; ++j) vv[j] = vp[j]; }
    {
        const int c = 16 * w + fr;
        const bf16x8 bfrag = __builtin_bit_cast(bf16x8, bw);
        const LAS float* LRS = (const LAS float*)(lds + G_LRS);
        float cum[4][4], tl[4], lower[4], T[4];
#pragma unroll
        for (int rt = 0; rt < 4; ++rt) {
            u32x4 aw = {0u, 0u, 0u, 0u};
            if (fq < 2) { const f32x4 l0 = *(const LAS f32x4*)(LRS + (16 * rt + fr) * 16 + 8 * fq), l1 = *(const LAS f32x4*)(LRS + (16 * rt + fr) * 16 + 8 * fq + 4);
                aw.x = pk2(l0[0], l0[1]); aw.y = pk2(l0[2], l0[3]); aw.z = pk2(l1[0], l1[1]); aw.w = pk2(l1[2], l1[3]); }
            const f32x4 lg = MFMA16(__builtin_bit_cast(bf16x8, aw), bfrag, ((f32x4){0.f, 0.f, 0.f, 0.f}));
            float run = 0.f;
#pragma unroll
            for (int i = 0; i < 4; ++i) { const float xg = lg[i] + bias; run += (fminf(xg, 0.f) - __logf(1.f + __expf(-fabsf(xg)))) * (1.f / 16.f); cum[rt][i] = run; }
            tl[rt] = run; }
#pragma unroll
        for (int rt = 0; rt < 4; ++rt) { const float a = __shfl_xor(tl[rt], 16), bq = __shfl_xor(tl[rt], 32), cc = __shfl_xor(tl[rt], 48);
            lower[rt] = ((fq & 1) ? a : 0.f) + ((fq & 2) ? (bq + cc) : 0.f); T[rt] = (tl[rt] + a) + (bq + cc); }
        float base = 0.f;
#pragma unroll
        for (int rt = 0; rt < 4; ++rt) { const float off = base + lower[rt];
#pragma unroll
            for (int i = 0; i < 4; ++i) CUM[(16 * rt + 4 * fq + i) * 129 + c] = cum[rt][i] + off;
            base += T[rt]; }
    }
    __syncthreads();
    {
        float qv[16], kv[16];
#pragma unroll
        for (int e = 0; e < 4; ++e) { qv[2 * e] = lo_f(q0[e]); qv[2 * e + 1] = hi_f(q0[e]); qv[8 + 2 * e] = lo_f(q1[e]); qv[8 + 2 * e + 1] = hi_f(q1[e]);
                                      kv[2 * e] = lo_f(k0[e]); kv[2 * e + 1] = hi_f(k0[e]); kv[8 + 2 * e] = lo_f(k1[e]); kv[8 + 2 * e + 1] = hi_f(k1[e]); }
        float qd[16], ki[16], kd[16];
#pragma unroll
        for (int j = 0; j < 16; ++j) { const float cu = CUM[t * 129 + c0 + j], cl = CUM[63 * 129 + c0 + j];
            qd[j] = qv[j] * 0.08838834764831845f * __expf(cu); ki[j] = kv[j] * __expf(-cu); kd[j] = kv[j] * __expf(cl - cu);
            if (t == 63) DN[c0 + j] = __expf(cl); }
        u32x4 a0, a1, b0, b1;
#pragma unroll
        for (int e = 0; e < 4; ++e) { a0[e] = pk2(qd[2 * e], qd[2 * e + 1]); a1[e] = pk2(qd[8 + 2 * e], qd[8 + 2 * e + 1]); b0[e] = pk2(ki[2 * e], ki[2 * e + 1]); b1[e] = pk2(ki[8 + 2 * e], ki[8 + 2 * e + 1]); }
        *(LAS u32x4*)(Qd + t * 136 + c0) = a0; *(LAS u32x4*)(Qd + t * 136 + c0 + 8) = a1;
        *(LAS u32x4*)(Ki + t * 136 + c0) = b0; *(LAS u32x4*)(Ki + t * 136 + c0 + 8) = b1;
        ((u32x4*)qp)[0] = a0; ((u32x4*)qp)[1] = a1;
#pragma unroll
        for (int j = 0; j < 16; ++j) KdT[(c0 + j) * 72 + t] = f2bf(kd[j]);
#pragma unroll
        for (int j = 0; j < 4; ++j)
#pragma unroll
            for (int e = 0; e < 4; ++e) { VT[(dv0 + 8 * j + 2 * e) * 72 + t] = (bf16)(vv[j][e] & 0xffffu); VT[(dv0 + 8 * j + 2 * e + 1) * 72 + t] = (bf16)(vv[j][e] >> 16); }
    }
    __syncthreads();
    {
        const int rt = w >> 1, ctb = (w & 1) * 2;
        f32x4 acc[2] = {(f32x4){0.f, 0.f, 0.f, 0.f}, (f32x4){0.f, 0.f, 0.f, 0.f}};
#pragma unroll
        for (int ks = 0; ks < 4; ++ks) { const bf16x8 a = *(const LAS bf16x8*)(Qd + (16 * rt + fr) * 136 + ks * 32 + fq * 8);
#pragma unroll
            for (int j = 0; j < 2; ++j) { const bf16x8 bb = *(const LAS bf16x8*)(Ki + (16 * (ctb + j) + fr) * 136 + ks * 32 + fq * 8); acc[j] = MFMA16(a, bb, acc[j]); } }
#pragma unroll
        for (int j = 0; j < 2; ++j)
#pragma unroll
            for (int i = 0; i < 4; ++i) { const int c = 16 * rt + 4 * fq + i, e = 16 * (ctb + j) + fr; Ps[c * 72 + e] = f2bf(e <= c ? acc[j][i] : 0.f); }
    }
    __syncthreads();
    {
        bf16x8 bv[2][2];
#pragma unroll
        for (int ks = 0; ks < 2; ++ks)
#pragma unroll
            for (int j = 0; j < 2; ++j) bv[ks][j] = *(const LAS bf16x8*)(VT + (16 * (2 * w + j) + fr) * 72 + ks * 32 + fq * 8);
        {
            f32x4 oi[4][2];
#pragma unroll
            for (int rt = 0; rt < 4; ++rt) { oi[rt][0] = (f32x4){0.f, 0.f, 0.f, 0.f}; oi[rt][1] = (f32x4){0.f, 0.f, 0.f, 0.f}; }
#pragma unroll
            for (int ks = 0; ks < 2; ++ks)
#pragma unroll
                for (int rt = 0; rt < 4; ++rt) { const bf16x8 a = *(const LAS bf16x8*)(Ps + (16 * rt + fr) * 72 + ks * 32 + fq * 8);
                    oi[rt][0] = MFMA16(bv[ks][0], a, oi[rt][0]); oi[rt][1] = MFMA16(bv[ks][1], a, oi[rt][1]); }
#pragma unroll
            for (int rt = 0; rt < 4; ++rt)
#pragma unroll
                for (int j = 0; j < 2; ++j) { u32x2 o; o.x = pk2(oi[rt][j][0], oi[rt][j][1]); o.y = pk2(oi[rt][j][2], oi[rt][j][3]);
                    *(u32x2*)(PR + (m0 + 16 * rt + fr) * NP + C_GLV + h * 256 + 16 * (2 * w + j) + 4 * fq) = o; }
        }
        {
#pragma unroll
            for (int rt = 0; rt < 8; ++rt) {
                f32x4 k0 = (f32x4){0.f, 0.f, 0.f, 0.f}, k1 = (f32x4){0.f, 0.f, 0.f, 0.f};
#pragma unroll
                for (int ks = 0; ks < 2; ++ks) { const bf16x8 a = *(const LAS bf16x8*)(KdT + (16 * rt + fr) * 72 + ks * 32 + fq * 8); k0 = MFMA16(a, bv[ks][0], k0); k1 = MFMA16(a, bv[ks][1], k1); }
                u32x2 s0, s1; s0.x = pk2(k0[0], k0[1]); s0.y = pk2(k0[2], k0[3]); s1.x = pk2(k1[0], k1[1]); s1.y = pk2(k1[2], k1[3]);
                *(u32x2*)(KVT + (size_t)(16 * (2 * w) + fr) * 128 + 16 * rt + 4 * fq) = s0;
                *(u32x2*)(KVT + (size_t)(16 * (2 * w + 1) + fr) * 128 + 16 * rt + 4 * fq) = s1;
            }
        }
    }
}

__device__ __forceinline__ void gla_scan(const Ptrs& P, LAS unsigned char* lds, int g, const int tid) {
    const int bh = g >> 3, e8 = (g & 7) * 512 + tid, dk0 = (e8 & 15) * 8;
    bf16* base = (bf16*)(P.ws + WS_KV) + (size_t)bh * NCHUNK * 32768 + (size_t)e8 * 8;
    LAS float* DS = (LAS float*)lds;
    __syncthreads();
    {   const f32x4* src = (const f32x4*)((const float*)(P.ws + WS_DN) + (size_t)bh * NCHUNK * 128);
#pragma unroll
        for (int i = 0; i < 4; ++i) *(LAS f32x4*)(DS + 4 * (tid + 512 * i)) = src[tid + 512 * i]; }
    __syncthreads();
    float S[8];
#pragma unroll
    for (int j = 0; j < 8; ++j) S[j] = 0.f;
    for (int n0 = 0; n0 < NCHUNK; n0 += 16) {
        u32x4 kv[16];
#pragma unroll
        for (int q = 0; q < 16; ++q) kv[q] = *(const u32x4*)(base + (size_t)(n0 + q) * 32768);
#pragma unroll
        for (int q = 0; q < 16; ++q) {
            const f32x4 d0 = *(const LAS f32x4*)(DS + (n0 + q) * 128 + dk0), d1 = *(const LAS f32x4*)(DS + (n0 + q) * 128 + dk0 + 4);
            u32x4 o; o.x = pk2(S[0], S[1]); o.y = pk2(S[2], S[3]); o.z = pk2(S[4], S[5]); o.w = pk2(S[6], S[7]);
            *(u32x4*)(base + (size_t)(n0 + q) * 32768) = o;
#pragma unroll
            for (int e = 0; e < 4; ++e) { const float dlo = e < 2 ? d0[2 * e] : d1[2 * e - 4], dhi = e < 2 ? d0[2 * e + 1] : d1[2 * e - 3];
                S[2 * e] = dlo * S[2 * e] + lo_f(kv[q][e]); S[2 * e + 1] = dhi * S[2 * e + 1] + hi_f(kv[q][e]); }
        }
    }
}

__device__ __forceinline__ void gla_out_unit(const Ptrs& P, LAS unsigned char* lds, int layer, int u, const int tid) {
    const int lane = tid & 63, w = __builtin_amdgcn_readfirstlane(tid >> 6), fr = lane & 15, fq = lane >> 4;
    const int bh = u >> 6, n = u & 63, b = bh >> 2, h = bh & 3;
    const size_t m0 = (size_t)b * SEQ + n * 64;
    const bf16* PR = (const bf16*)(P.ws + WS_PROJ);
    const bf16* KVT = (const bf16*)(P.ws + WS_KV) + (size_t)u * 32768;
    bf16* MIX = (bf16*)(P.ws + WS_MIX);
    LAS float* SS = (LAS float*)lds;
    __syncthreads();
    u32x2 oiv[4][2], gv[4][2];
    f32x4 ggv[2];
#pragma unroll
    for (int j = 0; j < 2; ++j) ggv[j] = *(const f32x4*)(P.gg + layer * 1024 + h * 256 + 16 * (2 * w + j) + 4 * fq);
#pragma unroll
    for (int rt = 0; rt < 4; ++rt)
#pragma unroll
        for (int j = 0; j < 2; ++j) { const bf16* rp = PR + (m0 + 16 * rt + fr) * NP + h * 256 + 16 * (2 * w + j) + 4 * fq; oiv[rt][j] = *(const u32x2*)(rp + C_GLV); gv[rt][j] = *(const u32x2*)(rp + C_GLG); }
    bf16x8 sf[4][2], qf[4][4];
#pragma unroll
    for (int ks = 0; ks < 4; ++ks) {
        sf[ks][0] = *(const bf16x8*)(KVT + (size_t)(16 * (2 * w) + fr) * 128 + ks * 32 + fq * 8);
        sf[ks][1] = *(const bf16x8*)(KVT + (size_t)(16 * (2 * w + 1) + fr) * 128 + ks * 32 + fq * 8);
#pragma unroll
        for (int rt = 0; rt < 4; ++rt) qf[ks][rt] = *(const bf16x8*)(PR + (m0 + 16 * rt + fr) * NP + C_GLQ + h * 128 + ks * 32 + fq * 8);
    }
    f32x4 acc[4][2];
#pragma unroll
    for (int rt = 0; rt < 4; ++rt) { acc[rt][0] = (f32x4){0.f, 0.f, 0.f, 0.f}; acc[rt][1] = (f32x4){0.f, 0.f, 0.f, 0.f}; }
#pragma unroll
    for (int ks = 0; ks < 4; ++ks)
#pragma unroll
        for (int rt = 0; rt < 4; ++rt) { acc[rt][0] = MFMA16(sf[ks][0], qf[ks][rt], acc[rt][0]); acc[rt][1] = MFMA16(sf[ks][1], qf[ks][rt], acc[rt][1]); }
#pragma unroll
    for (int rt = 0; rt < 4; ++rt) { float ss = 0.f;
#pragma unroll
        for (int j = 0; j < 2; ++j) { acc[rt][j][0] += lo_f(oiv[rt][j].x); acc[rt][j][1] += hi_f(oiv[rt][j].x); acc[rt][j][2] += lo_f(oiv[rt][j].y); acc[rt][j][3] += hi_f(oiv[rt][j].y);
            ss += (acc[rt][j][0] * acc[rt][j][0] + acc[rt][j][1] * acc[rt][j][1]) + (acc[rt][j][2] * acc[rt][j][2] + acc[rt][j][3] * acc[rt][j][3]); }
        ss += __shfl_xor(ss, 16); ss += __shfl_xor(ss, 32);
        if (fq == 0) SS[(16 * rt + fr) * 8 + w] = ss; }
    __syncthreads();
#pragma unroll
    for (int rt = 0; rt < 4; ++rt) { const int r = 16 * rt + fr; const size_t m = m0 + r;
        const f32x4 sa = *(const LAS f32x4*)(SS + r * 8), sb = *(const LAS f32x4*)(SS + r * 8 + 4);
        const float tot = ((sa[0] + sa[1]) + (sa[2] + sa[3])) + ((sb[0] + sb[1]) + (sb[2] + sb[3]));
        const float rs = rsqrtf(tot * (1.f / 256.f) + EPS);
#pragma unroll
        for (int j = 0; j < 2; ++j) { const int dv = h * 256 + 16 * (2 * w + j) + 4 * fq; const f32x4 gn = ggv[j];
            u32x2 o; o.x = pk2(acc[rt][j][0] * rs * gn[0] * silu(lo_f(gv[rt][j].x)), acc[rt][j][1] * rs * gn[1] * silu(hi_f(gv[rt][j].x)));
            o.y = pk2(acc[rt][j][2] * rs * gn[2] * silu(lo_f(gv[rt][j].y)), acc[rt][j][3] * rs * gn[3] * silu(hi_f(gv[rt][j].y)));
            *(u32x2*)(MIX + m * DM + 1024 + dv) = o; } }
}

#define XB_TMO      128
#define XB_XCNT(j)  (256  + 64 * (j))
#define XB_XSUB(j)  (1280 + 64 * (j))
#define XB_XGEN(j)  (2304 + 64 * (j))
#define XB_TOP      3328
#define XB_TOPGEN   3392
#define XCD_BAR_WORDS 3456
#define XB_SPIN_CAP (1u << 18)
__device__ __forceinline__ unsigned xb_ld(unsigned* p)              { return __hip_atomic_load(p, __ATOMIC_RELAXED, __HIP_MEMORY_SCOPE_AGENT); }
__device__ __forceinline__ unsigned xb_add(unsigned* p, unsigned v) { return __hip_atomic_fetch_add(p, v, __ATOMIC_RELAXED, __HIP_MEMORY_SCOPE_AGENT); }
__device__ __forceinline__ unsigned xb_xcc_id() { return (unsigned)__builtin_amdgcn_s_getreg((3 << 11) | 20) & 0xFu; }
#define XB_SPIN(cond, bar) do { unsigned _sp = 0; while (cond) { __builtin_amdgcn_s_sleep(1); \
    if ((++_sp & 255u) == 0u) { if (xb_ld(&(bar)[XB_TMO])) break; if (_sp > XB_SPIN_CAP) { atomicAdd(&(bar)[XB_TMO], 1u); break; } } } } while (0)
struct XcdBarrier { unsigned* bar; unsigned x; volatile LAS unsigned* st; };
__device__ __forceinline__ XcdBarrier xcd_barrier_post(unsigned* bar, volatile LAS unsigned* st) {
    XcdBarrier b; b.bar = bar; b.x = xb_xcc_id(); b.st = st;
    if (threadIdx.x == 0) (void)xb_add(&bar[XB_XCNT(b.x)], 1u);
    return b;
}
__device__ __forceinline__ void xcd_barrier_complete(unsigned* bar, unsigned x, unsigned& nloc, unsigned& nx) {
    const unsigned G = gridDim.x * gridDim.y * gridDim.z;
    unsigned sum, cnt, mine, sp = 0u;
    for (;;) {
        sum = 0u; cnt = 0u; mine = 0u;
#pragma unroll
        for (unsigned j = 0; j < 16; ++j) { const unsigned c = xb_ld(&bar[XB_XCNT(j)]); sum += c; cnt += (c > 0u) ? 1u : 0u; mine = (j == x) ? c : mine; }
        if (sum == G) break;
        __builtin_amdgcn_s_sleep(1);
        if ((++sp & 255u) == 0u) { if (xb_ld(&bar[XB_TMO])) break; if (sp > XB_SPIN_CAP) { atomicAdd(&bar[XB_TMO], 1u); break; } }
    }
    nloc = mine > 0u ? mine : 1u; nx = cnt > 0u ? cnt : 1u;
}
__device__ __forceinline__ void xcd_barrier(const XcdBarrier& b) {
    asm volatile("s_waitcnt vmcnt(0)" ::: "memory");
    __syncthreads();
    if (threadIdx.x == 0) {
        unsigned* bar = b.bar;
        __builtin_amdgcn_s_waitcnt(0);
        unsigned nloc = b.st[0], nx = b.st[1];
        if (nloc == 0u) { xcd_barrier_complete(bar, b.x, nloc, nx); b.st[0] = nloc; b.st[1] = nx; }
        const unsigned old = xb_add(&bar[XB_XSUB(b.x)], 1u);
        const unsigned gen = old / nloc;
        if (old + 1u == (gen + 1u) * nloc) {
            __builtin_amdgcn_fence(__ATOMIC_RELEASE, "agent");
            asm volatile("s_waitcnt vmcnt(0)" ::: "memory");
            const unsigned og = xb_add(&bar[XB_TOP], 1u);
            const unsigned tg = og / nx;
            if (og + 1u == (tg + 1u) * nx) xb_add(&bar[XB_TOPGEN], 1u);
            else XB_SPIN(xb_ld(&bar[XB_TOPGEN]) == tg, bar);
            __builtin_amdgcn_fence(__ATOMIC_ACQUIRE, "agent");
            xb_add(&bar[XB_XGEN(b.x)], 1u);
            asm volatile("s_waitcnt vmcnt(0)" ::: "memory");
        } else {
            XB_SPIN(xb_ld(&bar[XB_XGEN(b.x)]) == gen, bar);
            __builtin_amdgcn_fence(__ATOMIC_ACQUIRE, "agent");
            asm volatile("s_waitcnt vmcnt(0)" ::: "memory");
        }
    }
    __syncthreads();
}

struct Args { const float* in[10]; float* out; unsigned char* ws; int ph_lo, ph_hi; };
constexpr int PH_PER_LAYER = 6, N_PHASES = DEPTH * PH_PER_LAYER;
constexpr size_t WS_CTL = 0, CTL_ZERO_BYTES = 65536;
constexpr int MISC_OFF = LDS_BYTES - 64;


__global__ void __launch_bounds__(NTHR, 2) hybrid_fwd(Args args) {
    extern __shared__ __attribute__((aligned(16))) unsigned char smem[];
    cg::grid_group grid = cg::this_grid();
    if (args.ph_lo < 0) grid.sync();
    {   LAS unsigned* m = (LAS unsigned*)(smem + MISC_OFF); if (threadIdx.x < 16) m[threadIdx.x] = 0u; __syncthreads(); }
    (void)xcd_barrier_post((unsigned*)(args.ws + WS_CTL), (volatile LAS unsigned*)((LAS unsigned char*)smem + MISC_OFF) + 8);
    for (int ph = args.ph_lo; ph < args.ph_hi; ++ph) {
        int tid = threadIdx.x, g = blockIdx.x, G = gridDim.x;
        asm volatile("" : "+v"(tid)); asm volatile("" : "+s"(g)); asm volatile("" : "+s"(G));
        LAS unsigned char* lds = (LAS unsigned char*)smem;
        Ptrs P; P.x = args.in[0]; P.norm_gain = args.in[1]; P.w_in = args.in[2]; P.qg = args.in[3]; P.kg = args.in[4]; P.og = args.in[5]; P.wa = args.in[6]; P.ba = args.in[7]; P.gg = args.in[8]; P.w_out = args.in[9];
        size_t oz0 = 0, oz1 = 0; asm volatile("" : "+s"(oz0)); asm volatile("" : "+s"(oz1));
        P.out = args.out + oz1; P.ws = args.ws + oz0;
        const int layer = ph / PH_PER_LAYER, k = ph % PH_PER_LAYER;
        const float* xin = layer == 0 ? P.x : P.out;
        if (k == 0) {
            if (layer == 0) phase_weights(P, lds, G, tid, g);
            phase_rownorm(P, xin, layer, G, tid, g);
        } else if (k == 1) {
            pg8::Gemm gm{(const bf16*)(P.ws + WS_XN), (const bf16*)(P.ws + WS_WIN + layer * WIN_L), M, NP, DM}; pg8::StaticOrder S; S.init(M, NP, G, g);
            pg8::EpiBf16 E{(bf16*)(P.ws + WS_PROJ), NP};
            pg8::gemm_phase<pg8::EpiBf16, pg8::StaticOrder, false, true>(lds, gm, S, E, tid);
        } else if (k == 2) {
            for (int c = g; c < 256; c += G) {
                const int bb = c >> 6, nn = c & 63;
                u32x4 bwv[4]; float biasv[4];
                {   const int lane_ = tid & 63, fr_ = lane_ & 15, fq_ = lane_ >> 4, c_ = 16 * (tid >> 6) + fr_;
#pragma unroll
                    for (int hh = 0; hh < 4; ++hh) { biasv[hh] = P.ba[layer * 512 + hh * 128 + c_]; bwv[hh] = (u32x4){0u, 0u, 0u, 0u};
                        if (fq_ < 2) { const float* wp = P.wa + (size_t)layer * 16 * 512 + (size_t)(8 * fq_) * 512 + hh * 128 + c_;
                            bwv[hh].x = pk2(wp[0], wp[512]); bwv[hh].y = pk2(wp[1024], wp[1536]); bwv[hh].z = pk2(wp[2048], wp[2560]); bwv[hh].w = pk2(wp[3072], wp[3584]); } } }
                gla_lowrank(P, lds, layer, (size_t)bb * SEQ + nn * 64, tid);
#pragma unroll
                for (int hh = 0; hh < 4; ++hh) gla_local_unit(P, lds, layer, ((bb * 4 + hh) << 6) + nn, tid, bwv[hh], biasv[hh]);
            }
            if (G == 256) attn_unit(P, lds, layer, (g & 7) * 32 + (g >> 3), tid);
            else for (int u = g; u < 256; u += G) attn_unit(P, lds, layer, u, tid);
        } else if (k == 3) {
            for (int gg = g; gg < 128; gg += G) gla_scan(P, lds, gg, tid);
            if (G == 256) {
                const int xb = 256 + (g & 7) * 64, li = g >> 3;
                if (li < 16) attn_unit(P, lds, layer, xb + li, tid);
                else for (int j = 0; j < 3; ++j) attn_unit(P, lds, layer, xb + 16 + (li - 16) * 3 + j, tid);
            } else for (int u = 256 + g; u < 768; u += G) attn_unit(P, lds, layer, u, tid);
        } else if (k == 4) {
            for (int u = g; u < 1024; u += G) gla_out_unit(P, lds, layer, u, tid);
            if (G == 256) attn_unit(P, lds, layer, 768 + (g & 7) * 32 + (g >> 3), tid);
            else for (int u = 768 + g; u < 1024; u += G) attn_unit(P, lds, layer, u, tid);
        } else {
            pg8::Gemm gm{(const bf16*)(P.ws + WS_MIX), (const bf16*)(P.ws + WS_WOUT + layer * WOUT_L), M, DM, DM}; pg8::StaticOrder S; S.init(M, DM, G, g);
            pg8::EpiRes E{xin, P.out, DM, layer + 1 == DEPTH ? 1 : 0};
            pg8::gemm_phase<pg8::EpiRes, pg8::StaticOrder, true, true>(lds, gm, S, E, tid);
        }
        if (ph + 1 < args.ph_hi) { XcdBarrier b2; b2.bar = (unsigned*)(args.ws + WS_CTL); b2.x = xb_xcc_id(); b2.st = (volatile LAS unsigned*)((LAS unsigned char*)smem + MISC_OFF) + 8; xcd_barrier(b2); }
    }
}

extern "C" void kernel_launch(void* const* d_in, const int* in_sizes, int n_in, void* d_out, int out_size, void* d_ws, size_t ws_size, hipStream_t stream) {
    static int grid = 0;
    if (grid == 0) {
        if (n_in != 10 || out_size != M * DM || ws_size < WS_END) { fprintf(stderr, "kernel_launch: unexpected shapes (n_in %d out %d ws %zu)\n", n_in, out_size, ws_size); grid = -1; return; }
        int dev = 0, cus = 0, per_cu = 0;
        if (hipGetDevice(&dev) != hipSuccess || hipDeviceGetAttribute(&cus, hipDeviceAttributeMultiprocessorCount, dev) != hipSuccess) { grid = -1; return; }
        if (hipFuncSetAttribute((const void*)hybrid_fwd, hipFuncAttributeMaxDynamicSharedMemorySize, LDS_BYTES) != hipSuccess) { fprintf(stderr, "kernel_launch: hipFuncSetAttribute failed\n"); grid = -1; return; }
        if (hipOccupancyMaxActiveBlocksPerMultiprocessor(&per_cu, (const void*)hybrid_fwd, NTHR, LDS_BYTES) != hipSuccess || per_cu < 1) { fprintf(stderr, "kernel_launch: occupancy query says %d\n", per_cu); per_cu = 1; }
        (void)hipGetLastError();
        grid = cus;
    }
    if (grid < 0) return;
    if (hipMemsetAsync((char*)d_ws + WS_CTL, 0, CTL_ZERO_BYTES, stream) != hipSuccess) { fprintf(stderr, "kernel_launch: hipMemsetAsync failed\n"); return; }
    Args a{};
    for (int i = 0; i < 10; ++i) a.in[i] = (const float*)d_in[i];
    a.out = (float*)d_out; a.ws = (unsigned char*)d_ws; a.ph_lo = 0; a.ph_hi = N_PHASES;
#if MK_PER_PHASE
    for (int ph = 0; ph < N_PHASES; ++ph) { a.ph_lo = ph; a.ph_hi = ph + 1; hipLaunchKernelGGL(hybrid_fwd, dim3(grid), dim3(NTHR), LDS_BYTES, stream, a); }
#else
    void* kargs[] = {&a};
    hipError_t e = hipLaunchCooperativeKernel((const void*)hybrid_fwd, dim3(grid), dim3(NTHR), kargs, LDS_BYTES, stream);
    if (e != hipSuccess) fprintf(stderr, "cooperative launch failed: %s (grid %d)\n", hipGetErrorString(e), grid);
#endif
}
```

```cpp
#include <hip/hip_runtime.h>
#include <hip/hip_cooperative_groups.h>
#include <cstdio>
#include <cstdint>
namespace cg = cooperative_groups;
#ifndef MK_PER_PHASE
#define MK_PER_PHASE 0
#endif

namespace pg8 {
#define PG8_LAS __attribute__((address_space(3)))
typedef unsigned short bf16_t;
typedef short bf16x8 __attribute__((ext_vector_type(8)));
typedef float f32x4 __attribute__((ext_vector_type(4)));
typedef unsigned u32x4 __attribute__((ext_vector_type(4)));
constexpr int BM = 256, BK = 64, HALF = 128, HTB = HALF * BK * 2, STAGE_BYTES = 8 * HTB, NXCD = 8, WGM = 4;

__host__ __device__ __forceinline__ int lds_byte(int r, int c) { const int st = (r >> 4) * 2 + (c >> 5), rr = r & 15, cc = c & 31, ob = rr * 64 + cc * 2; return st * 1024 + (ob ^ (((ob >> 9) & 1) << 5)); }
__host__ __device__ __forceinline__ void stage_rc(int b, int& R, int& C) { const int st = b / 1024, sb = b % 1024, swz = sb ^ (((sb >> 9) & 1) << 5); R = (st >> 1) * 16 + swz / 64; C = (st & 1) * 32 + (swz % 64) / 2; }
__host__ __device__ __forceinline__ int perm32(int rho) { const int n = rho >> 4, i = rho & 15; return 8 * (i >> 2) + 4 * n + (i & 3); }

struct Unit { int pm, pn; };
struct Gemm { const bf16_t* A; const bf16_t* Bt; int M, N, K; };

struct StaticOrder {
    int nM, nN, nwg, G, c;
    __host__ __device__ void init(int M, int N, int G_, int c_) { nM = M / BM; nN = N / BM; nwg = nM * nN; G = G_; c = c_; }
    __host__ __device__ bool next(int i, Unit& u) const {
        const long L = (long)i * G + c; if (L >= nwg) return false;
        int wgid = (int)L; { const int q = nwg / NXCD, r = nwg % NXCD, xcd = wgid % NXCD, off = wgid / NXCD; wgid = (xcd < r ? xcd * (q + 1) : r * (q + 1) + (xcd - r) * q) + off; }
        const int nig = WGM * nN, gid = wgid / nig, fm = gid * WGM, gsz = (nM - fm) < WGM ? (nM - fm) : WGM;
        u.pm = fm + ((wgid % nig) % gsz); u.pn = (wgid % nig) / gsz; return true;
    }
    __device__ __forceinline__ void a_ready(const Unit&) const {}
    __device__ __forceinline__ void done(const Unit&) const {}
};

typedef float f32x2_t __attribute__((ext_vector_type(2)));
typedef __bf16 bf16x2_t __attribute__((ext_vector_type(2)));
__device__ __forceinline__ unsigned cvt_pk_bf16(float lo, float hi) { f32x2_t v = {lo, hi}; bf16x2_t b = __builtin_convertvector(v, bf16x2_t); return __builtin_bit_cast(unsigned, b); }

struct EpiBf16 {
    static constexpr bool PERM = true, AFTER_DRAIN = false;
    bf16_t* O; int ldc;
    __device__ __forceinline__ void operator()(const f32x4 (&acc)[2][2][4][2], const Unit& u, int wr, int wc, int fr, int fq) const {
        const int row0 = u.pm * BM + wr * 64 + fr; const int col0 = u.pn * BM + wc * 32 + 8 * fq;
#pragma unroll
        for (int ai = 0; ai < 2; ++ai)
#pragma unroll
            for (int m = 0; m < 4; ++m) { bf16_t* rowp = O + (size_t)(row0 + ai * HALF + m * 16) * ldc + col0;
#pragma unroll
                for (int bj = 0; bj < 2; ++bj) { const f32x4 v0 = acc[ai][bj][m][0], v1 = acc[ai][bj][m][1];
                    u32x4 w; w.x = cvt_pk_bf16(v0[0], v0[1]); w.y = cvt_pk_bf16(v0[2], v0[3]); w.z = cvt_pk_bf16(v1[0], v1[1]); w.w = cvt_pk_bf16(v1[2], v1[3]);
                    *(u32x4*)(rowp + bj * HALF) = w; } }
    }
};
struct EpiRes {
    static constexpr bool PERM = false, AFTER_DRAIN = false;
    const float* base; float* out; int ldc;
    __device__ __forceinline__ void operator()(const f32x4 (&acc)[2][2][4][2], const Unit& u, int wr, int wc, int fr, int fq) const {
        const int row0 = u.pm * BM + wr * 64 + fr; const int col0 = u.pn * BM + wc * 32 + 4 * fq;
#pragma unroll
        for (int ai = 0; ai < 2; ++ai)
#pragma unroll
            for (int mp = 0; mp < 2; ++mp) {
                f32x4 b[2][2][2];
#pragma unroll
                for (int mm = 0; mm < 2; ++mm) { const size_t off = (size_t)(row0 + ai * HALF + (2 * mp + mm) * 16) * ldc + col0;
#pragma unroll
                    for (int bj = 0; bj < 2; ++bj)
#pragma unroll
                        for (int n = 0; n < 2; ++n) b[mm][bj][n] = *(const f32x4*)(base + off + bj * HALF + n * 16); }
                asm volatile("" ::: "memory");
#pragma unroll
                for (int mm = 0; mm < 2; ++mm) { const size_t off = (size_t)(row0 + ai * HALF + (2 * mp + mm) * 16) * ldc + col0;
#pragma unroll
                    for (int bj = 0; bj < 2; ++bj)
#pragma unroll
                        for (int n = 0; n < 2; ++n) *(f32x4*)(out + off + bj * HALF + n * 16) = b[mm][bj][n] + acc[ai][bj][2 * mp + mm][n]; }
                asm volatile("" ::: "memory");
            }
    }
};

template <class Epi, class Sched, bool ALIGN_EPI = false, bool SP2 = false>
__device__ __forceinline__ void gemm_phase(PG8_LAS unsigned char* lds, const Gemm g, const Sched& S, const Epi& E, const int tid) {
    const int wid = __builtin_amdgcn_readfirstlane(tid >> 6), lane = tid & 63, wr = wid >> 2, wc = wid & 3, fr = lane & 15, fq = lane >> 4;
    const int K = g.K, nt = K / BK;
    unsigned voffA[2], voffB[2];
#pragma unroll
    for (int i = 0; i < 2; ++i) { int R, C; stage_rc(tid * 16 + i * 8192, R, C); const int Rb = Epi::PERM ? ((R & ~31) + perm32(R & 31)) : R;
        voffA[i] = (unsigned)(R * K + C) * 2u; voffB[i] = (unsigned)(Rb * K + C) * 2u; }
    const size_t kstep = (size_t)(BK * 2);
    const size_t hstep = (size_t)HALF * K * 2;
    const size_t tstep = 2 * hstep;
    const unsigned ldsw = (unsigned)wid * 1024u;
    const int aoff = lds_byte(wr * 64 + fr, fq * 8), boff = lds_byte(wc * 32 + fr, fq * 8);
#define PG8_SA(b, h) (((b) * 2 + (h)) * HTB)
#define PG8_SB(b, h) ((4 + (b) * 2 + (h)) * HTB)
#define PG8_STAGE(bufoff, gbase, voff) do { _Pragma("unroll") for (int _i = 0; _i < 2; ++_i) \
        __builtin_amdgcn_global_load_lds((const unsigned*)((const char*)(gbase) + (voff)[_i]), (PG8_LAS unsigned*)(lds + (bufoff) + ldsw + _i * 8192), 16, 0, 0); } while (0)
#define PG8_LDA(dst, b, h) do { _Pragma("unroll") for (int m = 0; m < 4; ++m) _Pragma("unroll") for (int k = 0; k < 2; ++k) dst[m][k] = *(const PG8_LAS bf16x8*)(lds + PG8_SA(b, h) + aoff + m * 2048 + k * 1024); } while (0)
#define PG8_LDB(dst, b, h) do { _Pragma("unroll") for (int n = 0; n < 2; ++n) _Pragma("unroll") for (int k = 0; k < 2; ++k) dst[n][k] = *(const PG8_LAS bf16x8*)(lds + PG8_SB(b, h) + boff + n * 2048 + k * 1024); } while (0)
#define PG8_MMA(ai, bj, At, Bt) do { __builtin_amdgcn_s_setprio(1); _Pragma("unroll") for (int m = 0; m < 4; ++m) _Pragma("unroll") for (int n = 0; n < 2; ++n) _Pragma("unroll") for (int k = 0; k < 2; ++k) \
        acc[ai][bj][m][n] = __builtin_amdgcn_mfma_f32_16x16x32_bf16(Bt[n][k], At[m][k], acc[ai][bj][m][n], 0, 0, 0); __builtin_amdgcn_s_setprio(0); } while (0)
#define PG8_WAIT_V(n) asm volatile("s_waitcnt vmcnt(" #n ")" ::: "memory")
#define PG8_WAIT_L(n) asm volatile("s_waitcnt lgkmcnt(" #n ")" ::: "memory")
#define PG8_BAR __builtin_amdgcn_s_barrier()
#define PG8_SCHED __builtin_amdgcn_sched_barrier(0)
    Unit cur, nxt; int ui = 0;
    if (!S.next(0, cur)) return;
    f32x4 acc[2][2][4][2];
#pragma unroll
    for (int a = 0; a < 2; ++a)
#pragma unroll
        for (int b = 0; b < 2; ++b)
#pragma unroll
            for (int m = 0; m < 4; ++m)
#pragma unroll
                for (int n = 0; n < 2; ++n) acc[a][b][m][n] = (f32x4){0.f, 0.f, 0.f, 0.f};
    bf16x8 At[4][2], B0[2][2], B1[2][2];
    const char* cA = (const char*)g.A + (size_t)cur.pm * tstep; const char* cB = (const char*)g.Bt + (size_t)cur.pn * tstep;
    S.a_ready(cur);
    if constexpr (SP2) {
        PG8_STAGE(PG8_SB(0, 0), cB, voffB); PG8_STAGE(PG8_SB(0, 1), cB + hstep, voffB); PG8_STAGE(PG8_SA(0, 0), cA, voffA); PG8_STAGE(PG8_SA(0, 1), cA + hstep, voffA);
        if (wr == 1) PG8_BAR;
        PG8_WAIT_V(2); PG8_BAR;
        PG8_STAGE(PG8_SB(1, 0), cB + kstep, voffB); PG8_STAGE(PG8_SA(1, 0), cA + kstep, voffA); PG8_STAGE(PG8_SB(1, 1), cB + hstep + kstep, voffB);
        PG8_WAIT_V(6); PG8_BAR;
    } else {
        PG8_STAGE(PG8_SB(0, 0), cB, voffB); PG8_STAGE(PG8_SA(0, 0), cA, voffA); PG8_STAGE(PG8_SB(0, 1), cB + hstep, voffB); PG8_STAGE(PG8_SA(0, 1), cA + hstep, voffA);
        if (wr == 1) PG8_BAR;
        PG8_WAIT_V(4); PG8_BAR;
        PG8_STAGE(PG8_SB(1, 0), cB + kstep, voffB); PG8_STAGE(PG8_SA(1, 0), cA + kstep, voffA); PG8_STAGE(PG8_SB(1, 1), cB + hstep + kstep, voffB);
        PG8_WAIT_V(6); PG8_BAR;
    }
    for (;;) {
        const bool has_next = S.next(ui + 1, nxt);
        const char* nA = has_next ? (const char*)g.A + (size_t)nxt.pm * tstep : cA; const char* nB = has_next ? (const char*)g.Bt + (size_t)nxt.pn * tstep : cB;
        for (int t = 0; t < nt; t += 2) {
            const bool last = (t == nt - 2);
            const char* a1 = cA + (size_t)(t + 1) * kstep;
            const char* a2 = last ? nA : cA + (size_t)(t + 2) * kstep; const char* b2 = last ? nB : cB + (size_t)(t + 2) * kstep;
            const char* a3 = a2 + kstep; const char* b3 = b2 + kstep;
            if (last && has_next) S.a_ready(nxt);
            if constexpr (SP2) {
            PG8_LDB(B0, 0, 0); PG8_LDB(B1, 0, 1); PG8_SCHED; PG8_LDA(At, 0, 0); PG8_STAGE(PG8_SA(1, 1), a1 + hstep, voffA);
            PG8_WAIT_V(8); PG8_WAIT_L(0); PG8_BAR; PG8_MMA(0, 0, At, B0); PG8_MMA(0, 1, At, B1); PG8_BAR; PG8_SCHED;
            PG8_LDA(At, 0, 1); PG8_STAGE(PG8_SB(0, 0), b2, voffB); PG8_STAGE(PG8_SB(0, 1), b2 + hstep, voffB); PG8_STAGE(PG8_SA(0, 0), a2, voffA);
            PG8_WAIT_V(8); PG8_WAIT_L(0); PG8_BAR; PG8_MMA(1, 0, At, B0); PG8_MMA(1, 1, At, B1); PG8_BAR; PG8_SCHED;
            PG8_LDB(B0, 1, 0); PG8_LDB(B1, 1, 1); PG8_SCHED; PG8_LDA(At, 1, 0); PG8_STAGE(PG8_SA(0, 1), a2 + hstep, voffA);
            PG8_WAIT_V(8); PG8_WAIT_L(0); PG8_BAR; PG8_MMA(0, 0, At, B0); PG8_MMA(0, 1, At, B1); PG8_BAR; PG8_SCHED;
            PG8_LDA(At, 1, 1); PG8_STAGE(PG8_SB(1, 0), b3, voffB); PG8_STAGE(PG8_SB(1, 1), b3 + hstep, voffB); PG8_STAGE(PG8_SA(1, 0), a3, voffA);
            PG8_WAIT_V(8); PG8_WAIT_L(0); PG8_BAR; PG8_MMA(1, 0, At, B0); PG8_MMA(1, 1, At, B1); PG8_BAR; PG8_SCHED;
            } else {
            PG8_LDB(B0, 0, 0); PG8_SCHED; PG8_LDA(At, 0, 0); PG8_STAGE(PG8_SA(1, 1), a1 + hstep, voffA);
            PG8_WAIT_L(8); PG8_BAR; PG8_WAIT_L(0); PG8_MMA(0, 0, At, B0); PG8_BAR; PG8_SCHED;
            PG8_LDB(B1, 0, 1); PG8_STAGE(PG8_SB(0, 0), b2, voffB);
            PG8_BAR; PG8_WAIT_L(0); PG8_MMA(0, 1, At, B1); PG8_BAR;
            PG8_LDA(At, 0, 1); PG8_STAGE(PG8_SA(0, 0), a2, voffA);
            PG8_BAR; PG8_WAIT_L(0); PG8_MMA(1, 0, At, B0); PG8_BAR; PG8_SCHED;
            PG8_STAGE(PG8_SB(0, 1), b2 + hstep, voffB);
            PG8_WAIT_V(6); PG8_BAR; PG8_MMA(1, 1, At, B1); PG8_BAR;
            PG8_LDB(B0, 1, 0); PG8_SCHED; PG8_LDA(At, 1, 0); PG8_STAGE(PG8_SA(0, 1), a2 + hstep, voffA);
            PG8_WAIT_L(8); PG8_BAR; PG8_WAIT_L(0); PG8_MMA(0, 0, At, B0); PG8_BAR; PG8_SCHED;
            PG8_LDB(B1, 1, 1); PG8_STAGE(PG8_SB(1, 0), b3, voffB);
            PG8_BAR; PG8_WAIT_L(0); PG8_MMA(0, 1, At, B1); PG8_BAR;
            PG8_LDA(At, 1, 1); PG8_STAGE(PG8_SA(1, 0), a3, voffA);
            PG8_BAR; PG8_WAIT_L(0); PG8_MMA(1, 0, At, B0); PG8_BAR; PG8_SCHED;
            PG8_STAGE(PG8_SB(1, 1), b3 + hstep, voffB);
            PG8_WAIT_V(6); PG8_BAR; PG8_MMA(1, 1, At, B1); PG8_BAR;
            }
        }
        if constexpr (ALIGN_EPI) { if (wr == 0) PG8_BAR; }
        if constexpr (!Epi::AFTER_DRAIN) { E(acc, cur, wr, wc, fr, fq); S.done(cur); }
        if (!has_next) break;
#pragma unroll
        for (int a = 0; a < 2; ++a)
#pragma unroll
            for (int b = 0; b < 2; ++b)
#pragma unroll
                for (int m = 0; m < 4; ++m)
#pragma unroll
                    for (int n = 0; n < 2; ++n) acc[a][b][m][n] = (f32x4){0.f, 0.f, 0.f, 0.f};
        cur = nxt; cA = nA; cB = nB; ++ui;
        if constexpr (ALIGN_EPI) { if (wr == 1) PG8_BAR; }
    }
    PG8_WAIT_V(0);
    if constexpr (!ALIGN_EPI) { if (wr == 0) PG8_BAR; }
    PG8_BAR;
#undef PG8_SA
#undef PG8_SB
#undef PG8_STAGE
#undef PG8_LDA
#undef PG8_LDB
#undef PG8_MMA
#undef PG8_WAIT_V
#undef PG8_WAIT_L
#undef PG8_BAR
#undef PG8_SCHED
}
}

#define LAS __attribute__((address_space(3)))
typedef unsigned short bf16;
typedef short bf16x8 __attribute__((ext_vector_type(8)));
typedef float f32x4 __attribute__((ext_vector_type(4)));
typedef unsigned u32x4 __attribute__((ext_vector_type(4)));
typedef unsigned u32x2 __attribute__((ext_vector_type(2)));

constexpr int NWAVES = 8, NTHR = 512;
constexpr int BATCH = 4, SEQ = 4096, DM = 2048, DEPTH = 2;
constexpr int M = BATCH * SEQ;
constexpr int INW = 7184;
constexpr int NP = 7168;
constexpr int C_SBQ = 0, C_SBK = 1024, C_SBV = 2048, C_SBG = 3072, C_GLQ = 4096, C_GLK = 4608, C_GLV = 5120, C_GLG = 6144;
constexpr float EPS = 1e-6f;
constexpr int NCHUNK = 64;
constexpr size_t MiB = 1u << 20;
constexpr size_t WS_WIN = 2 * MiB, WIN_L = (size_t)NP * DM * 2;
constexpr size_t WS_WOUT = 58 * MiB, WOUT_L = (size_t)DM * DM * 2;
constexpr size_t WS_PROJ = 74 * MiB;
constexpr size_t WS_XN = 298 * MiB;
constexpr size_t WS_MIX = 362 * MiB;
constexpr size_t WS_KV = 426 * MiB;
constexpr size_t WS_DN = 490 * MiB;
constexpr size_t WS_WLRT = 491 * MiB, WLRT_L = 16 * DM * 2;
constexpr size_t WS_END = 492 * MiB;
constexpr int LDS_BYTES = 147456;

__device__ __forceinline__ unsigned pk2(float lo, float hi) { return pg8::cvt_pk_bf16(lo, hi); }
__device__ __forceinline__ unsigned short f2bf(float f) { return (unsigned short)(pk2(f, 0.f) & 0xffffu); }
__device__ __forceinline__ float bf2f(unsigned short v) { return __uint_as_float((unsigned)v << 16); }
__device__ __forceinline__ float lo_f(unsigned w) { return __uint_as_float(w << 16); }
__device__ __forceinline__ float hi_f(unsigned w) { return __uint_as_float(w & 0xffff0000u); }
__device__ __forceinline__ float wave_sum(float v) {
#pragma unroll
    for (int o = 1; o < 64; o <<= 1) v += __shfl_xor(v, o);
    return v;
}
__device__ __forceinline__ float silu(float g) { return g / (1.f + __expf(-g)); }
__device__ __forceinline__ float softplus(float z) { return fmaxf(z, 0.f) + __logf(1.f + __expf(-fabsf(z))); }
#define LDS_WAIT() asm volatile("s_waitcnt lgkmcnt(0)" ::: "memory")
#define MFMA16(a, b, c) __builtin_amdgcn_mfma_f32_16x16x32_bf16((a), (b), (c), 0, 0, 0)

struct Ptrs {
    const float* x; const float* norm_gain; const float* w_in; const float* qg; const float* kg; const float* og; const float* wa; const float* ba; const float* gg; const float* w_out;
    float* out; unsigned char* ws;
};

__device__ __forceinline__ void transpose_item(const float* W, int ldw, int nblk, int K, bf16* WT, LAS float* scr, int item, int lane, bool late = false) {
    const int kb = item / nblk, nb = item % nblk, k0 = 64 * kb, n0 = 32 * nb;
#pragma unroll 8
    for (int i = 0; i < 32; ++i) { const int kk = 2 * i + (lane >> 5); scr[kk * 33 + (lane & 31)] = __builtin_nontemporal_load(W + (size_t)(k0 + kk) * ldw + n0 + (lane & 31)); }
    LDS_WAIT(); asm volatile("" ::: "memory");
    const int c = lane & 7;
#pragma unroll
    for (int j = 0; j < 4; ++j) { const int n = (lane >> 3) + 8 * j; const LAS float* s = scr + (8 * c) * 33 + n;
        u32x4 o; o.x = pk2(s[0 * 33], s[1 * 33]); o.y = pk2(s[2 * 33], s[3 * 33]); o.z = pk2(s[4 * 33], s[5 * 33]); o.w = pk2(s[6 * 33], s[7 * 33]);
        u32x4* dst = (u32x4*)(WT + (size_t)(n0 + n) * K + k0 + 8 * c); if (late) __builtin_nontemporal_store(o, dst); else *dst = o; }
    LDS_WAIT(); asm volatile("" ::: "memory");
}

__device__ __forceinline__ void phase_weights(const Ptrs& P, LAS unsigned char* lds, int G, const int tid, const int bid) {
    const int lane = tid & 63, wave = tid >> 6;
    LAS float* scr = (LAS float*)(lds + wave * 16384);
    const int gw = bid * NWAVES + wave, NGW = G * NWAVES;
    constexpr int I_IN = (DM / 64) * (7168 / 32), I_OUT = (DM / 64) * (DM / 32);
    for (int it = gw; it < DEPTH * (I_IN + I_OUT); it += NGW) {
        const int l = it / (I_IN + I_OUT); int r = it % (I_IN + I_OUT);
        if (r < I_IN) transpose_item(P.w_in + (size_t)l * DM * INW, INW, 7168 / 32, DM, (bf16*)(P.ws + WS_WIN + l * WIN_L), scr, r, lane, l > 0);
        else transpose_item(P.w_out + (size_t)l * DM * DM, DM, DM / 32, DM, (bf16*)(P.ws + WS_WOUT + l * WOUT_L), scr, r - I_IN, lane, l > 0);
    }
    for (int it = bid * NTHR + tid; it < DEPTH * 16 * DM; it += G * NTHR) {
        const int l = it / (16 * DM), r = (it / DM) & 15, d = it % DM;
        ((bf16*)(P.ws + WS_WLRT + l * WLRT_L))[r * DM + d] = f2bf(P.w_in[(size_t)l * DM * INW + (size_t)d * INW + 7168 + r]);
    }
}

__device__ __forceinline__ void phase_rownorm(const Ptrs& P, const float* xin, int layer, int G, const int tid, const int bid) {
    const int lane = tid & 63, wave = tid >> 6;
    const int gw = bid * NWAVES + wave, NGW = G * NWAVES;
    const f32x4* gp = (const f32x4*)(P.norm_gain + layer * DM) + lane;
    bf16* XN = (bf16*)(P.ws + WS_XN);
    for (int m = gw; m < M; m += NGW) {
        const f32x4* xr = (const f32x4*)(xin + (size_t)m * DM) + lane;
        f32x4 v[8]; float s = 0.f;
#pragma unroll
        for (int j = 0; j < 8; ++j) { v[j] = __builtin_nontemporal_load(xr + 64 * j); s += (v[j][0] * v[j][0] + v[j][1] * v[j][1]) + (v[j][2] * v[j][2] + v[j][3] * v[j][3]); }
        const float rs = rsqrtf(wave_sum(s) * (1.f / DM) + EPS);
        u32x2* o8 = (u32x2*)(XN + (size_t)m * DM) + lane;
#pragma unroll
        for (int j = 0; j < 8; ++j) { const f32x4 g = gp[64 * j]; u32x2 w; w.x = pk2(v[j][0] * rs * g[0], v[j][1] * rs * g[1]); w.y = pk2(v[j][2] * rs * g[2], v[j][3] * rs * g[3]); o8[64 * j] = w; }
    }
}

constexpr int AQ_LD = 136, AV_LD = 72;
constexpr int A_KS = 0, A_KS_SZ = 64 * AQ_LD * 2, A_VT = A_KS + 2 * A_KS_SZ, A_VT_SZ = 128 * AV_LD * 2, A_FLAG = A_VT + 2 * A_VT_SZ, A_END = A_FLAG + 64;
static_assert(A_END <= 131072, "attention LDS");

template <bool MASK>
__device__ __forceinline__ void sb_scan(const f32x4 (&z)[4], int kb, int tq, int fq, float& R, float (&p)[4][4]) {
    float be[4][4], nb[4][4], tl[4], up[4], T[4];
#pragma unroll
    for (int n = 0; n < 4; ++n) { float t = 1.f;
#pragma unroll
        for (int i = 0; i < 4; ++i) { const float z2 = fminf(fmaxf(z[n][i], -100.f), 100.f); const float e = __builtin_amdgcn_exp2f(-z2); const float r = __builtin_amdgcn_rcpf(1.f + e);
            float bb = r, qq = e * r;
            if (MASK) { const bool valid = (kb + 16 * n + i) < tq; bb = valid ? bb : 0.f; qq = valid ? qq : 1.f; }
            be[n][i] = bb; nb[n][i] = qq; t *= qq; }
        tl[n] = t; }
#pragma unroll
    for (int n = 0; n < 4; ++n) { const float a = __shfl_xor(tl[n], 16), bq = __shfl_xor(tl[n], 32), c = __shfl_xor(tl[n], 48);
        up[n] = ((fq & 1) ? 1.f : a) * ((fq & 2) ? 1.f : (bq * c)); T[n] = (tl[n] * a) * (bq * c); }
    float base = R;
#pragma unroll
    for (int n = 3; n >= 0; --n) { float run = base * up[n];
#pragma unroll
        for (int i = 3; i >= 0; --i) { p[n][i] = be[n][i] * run; run *= nb[n][i]; }
        base *= T[n]; }
    R = base;
}

__device__ __forceinline__ void attn_unit(const Ptrs& P, LAS unsigned char* lds, int layer, int u, const int tid) {
    const int lane = tid & 63, w = __builtin_amdgcn_readfirstlane(tid >> 6), fr = lane & 15, fq = lane >> 4;
    const int bh = u >> 5, qb = u & 31, b = bh >> 3, h = bh & 7;
    const int t0 = qb * 128, rowbase = b * SEQ;
    const bf16* PR = (const bf16*)(P.ws + WS_PROJ);
    bf16* MIX = (bf16*)(P.ws + WS_MIX);
    const int kr = tid >> 3, kpart = tid & 7;
    const size_t kvoff = (size_t)rowbase * NP + h * 128 + kpart * 16;
    const size_t vvoff = (size_t)(rowbase + lane) * NP + C_SBV + h * 128 + 16 * w;
    u32x4 k0, k1, v0, v1;
#define ATT_ISSUE(kt_) do { const bf16* rp_ = PR + kvoff + (size_t)((kt_) * 64 + kr) * NP; k0 = ((const u32x4*)(rp_ + C_SBK))[0]; k1 = ((const u32x4*)(rp_ + C_SBK))[1]; \
                            const bf16* vp_ = PR + vvoff + (size_t)((kt_) * 64) * NP; v0 = ((const u32x4*)vp_)[0]; v1 = ((const u32x4*)vp_)[1]; } while (0)
    ATT_ISSUE(2 * qb + 1);
    const int tq = t0 + 16 * w + fr;
    bf16x8 qf[4];
    {
        const u32x4* src = (const u32x4*)(PR + (size_t)(rowbase + tq) * NP + C_SBQ + h * 128 + fq * 8);
        u32x4 wv[4]; float ss = 0.f;
#pragma unroll
        for (int ks = 0; ks < 4; ++ks) wv[ks] = src[ks * 4];
#pragma unroll
        for (int ks = 0; ks < 4; ++ks)
#pragma unroll
            for (int e = 0; e < 4; ++e) { const float a = lo_f(wv[ks][e]), c = hi_f(wv[ks][e]); ss += a * a + c * c; }
        ss += __shfl_xor(ss, 16); ss += __shfl_xor(ss, 32);
        const float rs = rsqrtf(ss * (1.f / 128.f) + EPS) * (0.08838834764831845f * 1.4426950408889634f);
#pragma unroll
        for (int ks = 0; ks < 4; ++ks) { const float* g = P.qg + layer * 128 + ks * 32 + fq * 8; u32x4 o;
#pragma unroll
            for (int e = 0; e < 4; ++e) o[e] = pk2(lo_f(wv[ks][e]) * rs * g[2 * e], hi_f(wv[ks][e]) * rs * g[2 * e + 1]);
            qf[ks] = __builtin_bit_cast(bf16x8, o); }
    }
    f32x4 oacc[8];
#pragma unroll
    for (int n = 0; n < 8; ++n) oacc[n] = (f32x4){0.f, 0.f, 0.f, 0.f};
    float R = 1.f;
    int done = 0, cur = 0;
    float kgain[16];
#pragma unroll
    for (int j = 0; j < 16; ++j) kgain[j] = P.kg[layer * 128 + kpart * 16 + j];
    __syncthreads();
    for (int kt = 2 * qb + 1; kt >= 0; --kt) {
        LAS bf16* Ks = (LAS bf16*)(lds + A_KS + cur * A_KS_SZ); LAS bf16* Vt = (LAS bf16*)(lds + A_VT + cur * A_VT_SZ);
        {
            float kv[16]; float ss = 0.f;
#pragma unroll
            for (int e = 0; e < 4; ++e) { kv[2 * e] = lo_f(k0[e]); kv[2 * e + 1] = hi_f(k0[e]); kv[8 + 2 * e] = lo_f(k1[e]); kv[8 + 2 * e + 1] = hi_f(k1[e]); }
#pragma unroll
            for (int j = 0; j < 16; ++j) ss += kv[j] * kv[j];
            ss += __shfl_xor(ss, 1); ss += __shfl_xor(ss, 2); ss += __shfl_xor(ss, 4);
            const float rs = rsqrtf(ss * (1.f / 128.f) + EPS);
            u32x4 o0, o1;
#pragma unroll
            for (int e = 0; e < 4; ++e) { o0[e] = pk2(kv[2 * e] * rs * kgain[2 * e], kv[2 * e + 1] * rs * kgain[2 * e + 1]); o1[e] = pk2(kv[8 + 2 * e] * rs * kgain[8 + 2 * e], kv[8 + 2 * e + 1] * rs * kgain[8 + 2 * e + 1]); }
            *(LAS u32x4*)(Ks + kr * AQ_LD + kpart * 16) = o0; *(LAS u32x4*)(Ks + kr * AQ_LD + kpart * 16 + 8) = o1;
#pragma unroll
            for (int e = 0; e < 4; ++e) {
                Vt[(16 * w + 2 * e) * AV_LD + lane] = (bf16)(v0[e] & 0xffffu); Vt[(16 * w + 2 * e + 1) * AV_LD + lane] = (bf16)(v0[e] >> 16);
                Vt[(16 * w + 8 + 2 * e) * AV_LD + lane] = (bf16)(v1[e] & 0xffffu); Vt[(16 * w + 8 + 2 * e + 1) * AV_LD + lane] = (bf16)(v1[e] >> 16); }
        }
        if (kt > 0) ATT_ISSUE(kt - 1);
        const bool wall = __builtin_amdgcn_ballot_w64(done != 0) == ~0ull;
        {
            LAS unsigned* fl = (LAS unsigned*)(lds + A_FLAG) + cur * 8;
            if (lane == 0) fl[w] = wall ? 1u : 0u;
            __syncthreads();
            const u32x4 fa = *(const LAS u32x4*)fl, fb = *(const LAS u32x4*)(fl + 4);
            if ((fa.x & fa.y & fa.z & fa.w & fb.x & fb.y & fb.z & fb.w) != 0u) break;
        }
        if (!wall && kt * 64 < t0 + 16 * w + 16) {
        f32x4 z[4];
#pragma unroll
        for (int n = 0; n < 4; ++n) z[n] = (f32x4){0.f, 0.f, 0.f, 0.f};
#pragma unroll
        for (int ks = 0; ks < 4; ++ks)
#pragma unroll
            for (int n = 0; n < 4; ++n) { const bf16x8 ka = *(const LAS bf16x8*)(Ks + (16 * n + fr) * AQ_LD + ks * 32 + fq * 8); z[n] = MFMA16(ka, qf[ks], z[n]); }
        float p[4][4];
        if (kt >= 2 * qb) sb_scan<true>(z, kt * 64 + 4 * fq, tq, fq, R, p); else sb_scan<false>(z, kt * 64 + 4 * fq, tq, fq, R, p);
        done = (R == 0.f);
#pragma unroll
        for (int s2 = 0; s2 < 2; ++s2) { u32x4 pw; pw.x = pk2(p[2 * s2][0], p[2 * s2][1]); pw.y = pk2(p[2 * s2][2], p[2 * s2][3]); pw.z = pk2(p[2 * s2 + 1][0], p[2 * s2 + 1][1]); pw.w = pk2(p[2 * s2 + 1][2], p[2 * s2 + 1][3]);
            const bf16x8 pb = __builtin_bit_cast(bf16x8, pw);
#pragma unroll
            for (int m = 0; m < 8; ++m) { const LAS bf16* vr = Vt + (16 * m + fr) * AV_LD + 32 * s2 + 4 * fq;
                u32x4 vw; const u32x2 lo = *(const LAS u32x2*)vr, hi = *(const LAS u32x2*)(vr + 16); vw.x = lo.x; vw.y = lo.y; vw.z = hi.x; vw.w = hi.y;
                oacc[m] = MFMA16(__builtin_bit_cast(bf16x8, vw), pb, oacc[m]); } }
        }
        cur ^= 1;
    }
#undef ATT_ISSUE
    {
        const size_t m = (size_t)(rowbase + tq);
        u32x2 gv[8];
#pragma unroll
        for (int n = 0; n < 8; ++n) gv[n] = *(const u32x2*)(PR + m * NP + C_SBG + h * 128 + 16 * n + 4 * fq);
        f32x4 gnv[8];
#pragma unroll
        for (int n = 0; n < 8; ++n) gnv[n] = *(const f32x4*)(P.og + layer * 1024 + h * 128 + 16 * n + 4 * fq);
        float ss = 0.f;
#pragma unroll
        for (int n = 0; n < 8; ++n) ss += (oacc[n][0] * oacc[n][0] + oacc[n][1] * oacc[n][1]) + (oacc[n][2] * oacc[n][2] + oacc[n][3] * oacc[n][3]);
        ss += __shfl_xor(ss, 16); ss += __shfl_xor(ss, 32);
        const float rs = rsqrtf(ss * (1.f / 128.f) + EPS);
#pragma unroll
        for (int n = 0; n < 8; ++n) { const int d = h * 128 + 16 * n + 4 * fq; const f32x4 gn = gnv[n];
            u32x2 o; o.x = pk2(oacc[n][0] * rs * gn[0] * silu(lo_f(gv[n].x)), oacc[n][1] * rs * gn[1] * silu(hi_f(gv[n].x)));
            o.y = pk2(oacc[n][2] * rs * gn[2] * silu(lo_f(gv[n].y)), oacc[n][3] * rs * gn[3] * silu(hi_f(gv[n].y)));
            *(u32x2*)(MIX + m * DM + d) = o; }
    }
}

constexpr int G_LRS = 137216, G_LRP = 0;
__device__ __forceinline__ void gla_lowrank(const Ptrs& P, LAS unsigned char* lds, int layer, size_t m0, const int tid) {
    const int lane = tid & 63, w = __builtin_amdgcn_readfirstlane(tid >> 6), fr = lane & 15, fq = lane >> 4;
    const bf16* XN = (const bf16*)(P.ws + WS_XN); const bf16* WL = (const bf16*)(P.ws + WS_WLRT + layer * WLRT_L);
    LAS float* LRP = (LAS float*)(lds + G_LRP); LAS float* LRS = (LAS float*)(lds + G_LRS);
    __syncthreads();
    f32x4 acc[4];
#pragma unroll
    for (int rt = 0; rt < 4; ++rt) acc[rt] = (f32x4){0.f, 0.f, 0.f, 0.f};
#pragma unroll
    for (int kh = 0; kh < 2; ++kh) {
        bf16x8 bf[4], af[4][4];
#pragma unroll
        for (int k4 = 0; k4 < 4; ++k4) { const int kk = 256 * w + (4 * kh + k4) * 32 + fq * 8; bf[k4] = *(const bf16x8*)(WL + fr * DM + kk);
#pragma unroll
            for (int rt = 0; rt < 4; ++rt) af[k4][rt] = *(const bf16x8*)(XN + (m0 + 16 * rt + fr) * DM + kk); }
#pragma unroll
        for (int k4 = 0; k4 < 4; ++k4)
#pragma unroll
            for (int rt = 0; rt < 4; ++rt) acc[rt] = MFMA16(af[k4][rt], bf[k4], acc[rt]);
    }
#pragma unroll
    for (int rt = 0; rt < 4; ++rt)
#pragma unroll
        for (int i = 0; i < 4; ++i) LRP[(w * 64 + 16 * rt + 4 * fq + i) * 16 + fr] = acc[rt][i];
    __syncthreads();
#pragma unroll
    for (int e = 0; e < 2; ++e) { const int o = tid + 512 * e; float sum = 0.f;
#pragma unroll
        for (int ww = 0; ww < 8; ++ww) sum += LRP[ww * 1024 + o];
        LRS[o] = sum; }
    __syncthreads();
}

constexpr int G_CUM = 0, G_PS = 126976, G_QD = 64 * 132 * 4, G_KI = G_QD + 64 * 136 * 2, G_KDT = G_KI + 64 * 136 * 2, G_VT = G_KDT + 128 * 72 * 2, G_TOT = G_VT + 256 * 72 * 2, G_END = G_TOT + 4 * 128 * 4;
static_assert(G_END <= G_PS && G_PS + 64 * 72 * 2 <= LDS_BYTES, "gla LDS");

__device__ __forceinline__ void gla_local_unit(const Ptrs& P, LAS unsigned char* lds, int layer, int u, const int tid, const u32x4 bw, const float bias) {
    const int lane = tid & 63, w = __builtin_amdgcn_readfirstlane(tid >> 6), fr = lane & 15, fq = lane >> 4;
    const int bh = u >> 6, n = u & 63, b = bh >> 2, h = bh & 3;
    const size_t m0 = (size_t)b * SEQ + n * 64;
    bf16* PR = (bf16*)(P.ws + WS_PROJ);
    bf16* KVT = (bf16*)(P.ws + WS_KV) + (size_t)u * 32768;
    float* DN = (float*)(P.ws + WS_DN) + (size_t)u * 128;
    LAS float* CUM = (LAS float*)(lds + G_CUM); LAS bf16* Ps = (LAS bf16*)(lds + G_PS); LAS bf16* Qd = (LAS bf16*)(lds + G_QD); LAS bf16* Ki = (LAS bf16*)(lds + G_KI);
    LAS bf16* KdT = (LAS bf16*)(lds + G_KDT); LAS bf16* VT = (LAS bf16*)(lds + G_VT); LAS float* TOT = (LAS float*)(lds + G_TOT);
    __syncthreads();
    const int t = lane, c0 = 16 * w, dv0 = 32 * w;
    bf16* qp = PR + (m0 + t) * NP + C_GLQ + h * 128 + c0; const bf16* kp = PR + (m0 + t) * NP + C_GLK + h * 128 + c0;
    const u32x4 q0 = ((const u32x4*)qp)[0], q1 = ((const u32x4*)qp)[1], k0 = ((const u32x4*)kp)[0], k1 = ((const u32x4*)kp)[1];
    u32x4 vv[4];
    {   const u32x4* vp = (const u32x4*)(PR + (m0 + t) * NP + C_GLV + h * 256 + dv0);
#pragma unroll
        for (int j = 0; j < 4; ++j) vv[j] = vp[j]; }
    {
        const int c = 16 * w + fr;
        const bf16x8 bfrag = __builtin_bit_cast(bf16x8, bw);
        const LAS float* LRS = (const LAS float*)(lds + G_LRS);
        float cum[4][4], tl[4], lower[4], T[4];
#pragma unroll
        for (int rt = 0; rt < 4; ++rt) {
            u32x4 aw = {0u, 0u, 0u, 0u};
            if (fq < 2) { const f32x4 l0 = *(const LAS f32x4*)(LRS + (16 * rt + fr) * 16 + 8 * fq), l1 = *(const LAS f32x4*)(LRS + (16 * rt + fr) * 16 + 8 * fq + 4);
                aw.x = pk2(l0[0], l0[1]); aw.y = pk2(l0[2], l0[3]); aw.z = pk2(l1[0], l1[1]); aw.w = pk2(l1[2], l1[3]); }
            const f32x4 lg = MFMA16(__builtin_bit_cast(bf16x8, aw), bfrag, ((f32x4){0.f, 0.f, 0.f, 0.f}));
            float run = 0.f;
#pragma unroll
            for (int i = 0; i < 4; ++i) { const float xg = lg[i] + bias; run += (fminf(xg, 0.f) - __logf(1.f + __expf(-fabsf(xg)))) * (1.f / 16.f); cum[rt][i] = run; }
            tl[rt] = run; }
#pragma unroll
        for (int rt = 0; rt < 4; ++rt) { const float a = __shfl_xor(tl[rt], 16), bq = __shfl_xor(tl[rt], 32), cc = __shfl_xor(tl[rt], 48);
            lower[rt] = ((fq & 1) ? a : 0.f) + ((fq & 2) ? (bq + cc) : 0.f); T[rt] = (tl[rt] + a) + (bq + cc); }
        float base = 0.f;
#pragma unroll
        for (int rt = 0; rt < 4; ++rt) { const float off = base + lower[rt];
#pragma unroll
            for (int i = 0; i < 4; ++i) CUM[(16 * rt + 4 * fq + i) * 129 + c] = cum[rt][i] + off;
            base += T[rt]; }
    }
    __syncthreads();
    {
        float qv[16], kv[16];
#pragma unroll
        for (int e = 0; e < 4; ++e) { qv[2 * e] = lo_f(q0[e]); qv[2 * e + 1] = hi_f(q0[e]); qv[8 + 2 * e] = lo_f(q1[e]); qv[8 + 2 * e + 1] = hi_f(q1[e]);
                                      kv[2 * e] = lo_f(k0[e]); kv[2 * e + 1] = hi_f(k0[e]); kv[8 + 2 * e] = lo_f(k1[e]); kv[8 + 2 * e + 1] = hi_f(k1[e]); }
        float qd[16], ki[16], kd[16];
#pragma unroll
        for (int j = 0; j < 16; ++j) { const float cu = CUM[t * 129 + c0 + j], cl = CUM[63 * 129 + c0 + j];
            qd[j] = qv[j] * 0.08838834764831845f * __expf(cu); ki[j] = kv[j] * __expf(-cu); kd[j] = kv[j] * __expf(cl - cu);
            if (t == 63) DN[c0 + j] = __expf(cl); }
        u32x4 a0, a1, b0, b1;
#pragma unroll
        for (int e = 0; e < 4; ++e) { a0[e] = pk2(qd[2 * e], qd[2 * e + 1]); a1[e] = pk2(qd[8 + 2 * e], qd[8 + 2 * e + 1]); b0[e] = pk2(ki[2 * e], ki[2 * e + 1]); b1[e] = pk2(ki[8 + 2 * e], ki[8 + 2 * e + 1]); }
        *(LAS u32x4*)(Qd + t * 136 + c0) = a0; *(LAS u32x4*)(Qd + t * 136 + c0 + 8) = a1;
        *(LAS u32x4*)(Ki + t * 136 + c0) = b0; *(LAS u32x4*)(Ki + t * 136 + c0 + 8) = b1;
        ((u32x4*)qp)[0] = a0; ((u32x4*)qp)[1] = a1;
#pragma unroll
        for (int j = 0; j < 16; ++j) KdT[(c0 + j) * 72 + t] = f2bf(kd[j]);
#pragma unroll
        for (int j = 0; j < 4; ++j)
#pragma unroll
            for (int e = 0; e < 4; ++e) { VT[(dv0 + 8 * j + 2 * e) * 72 + t] = (bf16)(vv[j][e] & 0xffffu); VT[(dv0 + 8 * j + 2 * e + 1) * 72 + t] = (bf16)(vv[j][e] >> 16); }
    }
    __syncthreads();
    {
        const int rt = w >> 1, ctb = (w & 1) * 2;
        f32x4 acc[2] = {(f32x4){0.f, 0.f, 0.f, 0.f}, (f32x4){0.f, 0.f, 0.f, 0.f}};
#pragma unroll
        for (int ks = 0; ks < 4; ++ks) { const bf16x8 a = *(const LAS bf16x8*)(Qd + (16 * rt + fr) * 136 + ks * 32 + fq * 8);
#pragma unroll
            for (int j = 0; j < 2; ++j) { const bf16x8 bb = *(const LAS bf16x8*)(Ki + (16 * (ctb + j) + fr) * 136 + ks * 32 + fq * 8); acc[j] = MFMA16(a, bb, acc[j]); } }
#pragma unroll
        for (int j = 0; j < 2; ++j)
#pragma unroll
            for (int i = 0; i < 4; ++i) { const int c = 16 * rt + 4 * fq + i, e = 16 * (ctb + j) + fr; Ps[c * 72 + e] = f2bf(e <= c ? acc[j][i] : 0.f); }
    }
    __syncthreads();
    {
        bf16x8 bv[2][2];
#pragma unroll
        for (int ks = 0; ks < 2; ++ks)
#pragma unroll
            for (int j = 0; j < 2; ++j) bv[ks][j] = *(const LAS bf16x8*)(VT + (16 * (2 * w + j) + fr) * 72 + ks * 32 + fq * 8);
        {
            f32x4 oi[4][2];
#pragma unroll
            for (int rt = 0; rt < 4; ++rt) { oi[rt][0] = (f32x4){0.f, 0.f, 0.f, 0.f}; oi[rt][1] = (f32x4){0.f, 0.f, 0.f, 0.f}; }
#pragma unroll
            for (int ks = 0; ks < 2; ++ks)
#pragma unroll
                for (int rt = 0; rt < 4; ++rt) { const bf16x8 a = *(const LAS bf16x8*)(Ps + (16 * rt + fr) * 72 + ks * 32 + fq * 8);
                    oi[rt][0] = MFMA16(bv[ks][0], a, oi[rt][0]); oi[rt][1] = MFMA16(bv[ks][1], a, oi[rt][1]); }
#pragma unroll
            for (int rt = 0; rt < 4; ++rt)
#pragma unroll
                for (int j = 0; j < 2; ++j) { u32x2 o; o.x = pk2(oi[rt][j][0], oi[rt][j][1]); o.y = pk2(oi[rt][j][2], oi[rt][j][3]);
                    *(u32x2*)(PR + (m0 + 16 * rt + fr) * NP + C_GLV + h * 256 + 16 * (2 * w + j) + 4 * fq) = o; }
        }
        {
#pragma unroll
            for (int rt = 0; rt < 8; ++rt) {
                f32x4 k0 = (f32x4){0.f, 0.f, 0.f, 0.f}, k1 = (f32x4){0.f, 0.f, 0.f, 0.f};
#pragma unroll
                for (int ks = 0; ks < 2; ++ks) { const bf16x8 a = *(const LAS bf16x8*)(KdT + (16 * rt + fr) * 72 + ks * 32 + fq * 8); k0 = MFMA16(a, bv[ks][0], k0); k1 = MFMA16(a, bv[ks][1], k1); }
                u32x2 s0, s1; s0.x = pk2(k0[0], k0[1]); s0.y = pk2(k0[2], k0[3]); s1.x = pk2(k1[0], k1[1]); s1.y = pk2(k1[2], k1[3]);
                *(u32x2*)(KVT + (size_t)(16 * (2 * w) + fr) * 128 + 16 * rt + 4 * fq) = s0;
                *(u32x2*)(KVT + (size_t)(16 * (2 * w + 1) + fr) * 128 + 16 * rt + 4 * fq) = s1;
            }
        }
    }
}

__device__ __forceinline__ void gla_scan(const Ptrs& P, LAS unsigned char* lds, int g, const int tid) {
    const int bh = g >> 3, e8 = (g & 7) * 512 + tid, dk0 = (e8 & 15) * 8;
    bf16* base = (bf16*)(P.ws + WS_KV) + (size_t)bh * NCHUNK * 32768 + (size_t)e8 * 8;
    LAS float* DS = (LAS float*)lds;
    __syncthreads();
    {   const f32x4* src = (const f32x4*)((const float*)(P.ws + WS_DN) + (size_t)bh * NCHUNK * 128);
#pragma unroll
        for (int i = 0; i < 4; ++i) *(LAS f32x4*)(DS + 4 * (tid + 512 * i)) = src[tid + 512 * i]; }
    __syncthreads();
    float S[8];
#pragma unroll
    for (int j = 0; j < 8; ++j) S[j] = 0.f;
    for (int n0 = 0; n0 < NCHUNK; n0 += 16) {
        u32x4 kv[16];
#pragma unroll
        for (int q = 0; q < 16; ++q) kv[q] = *(const u32x4*)(base + (size_t)(n0 + q) * 32768);
#pragma unroll
        for (int q = 0; q < 16; ++q) {
            const f32x4 d0 = *(const LAS f32x4*)(DS + (n0 + q) * 128 + dk0), d1 = *(const LAS f32x4*)(DS + (n0 + q) * 128 + dk0 + 4);
            u32x4 o; o.x = pk2(S[0], S[1]); o.y = pk2(S[2], S[3]); o.z = pk2(S[4], S[5]); o.w = pk2(S[6], S[7]);
            *(u32x4*)(base + (size_t)(n0 + q) * 32768) = o;
#pragma unroll
            for (int e = 0; e < 4; ++e) { const float dlo = e < 2 ? d0[2 * e] : d1[2 * e - 4], dhi = e < 2 ? d0[2 * e + 1] : d1[2 * e - 3];
                S[2 * e] = dlo * S[2 * e] + lo_f(kv[q][e]); S[2 * e + 1] = dhi * S[2 * e + 1] + hi_f(kv[q][e]); }
        }
    }
}

__device__ __forceinline__ void gla_out_unit(const Ptrs& P, LAS unsigned char* lds, int layer, int u, const int tid) {
    const int lane = tid & 63, w = __builtin_amdgcn_readfirstlane(tid >> 6), fr = lane & 15, fq = lane >> 4;
    const int bh = u >> 6, n = u & 63, b = bh >> 2, h = bh & 3;
    const size_t m0 = (size_t)b * SEQ + n * 64;
    const bf16* PR = (const bf16*)(P.ws + WS_PROJ);
    const bf16* KVT = (const bf16*)(P.ws + WS_KV) + (size_t)u * 32768;
    bf16* MIX = (bf16*)(P.ws + WS_MIX);
    LAS float* SS = (LAS float*)lds;
    __syncthreads();
    u32x2 oiv[4][2], gv[4][2];
    f32x4 ggv[2];
#pragma unroll
    for (int j = 0; j < 2; ++j) ggv[j] = *(const f32x4*)(P.gg + layer * 1024 + h * 256 + 16 * (2 * w + j) + 4 * fq);
#pragma unroll
    for (int rt = 0; rt < 4; ++rt)
#pragma unroll
        for (int j = 0; j < 2; ++j) { const bf16* rp = PR + (m0 + 16 * rt + fr) * NP + h * 256 + 16 * (2 * w + j) + 4 * fq; oiv[rt][j] = *(const u32x2*)(rp + C_GLV); gv[rt][j] = *(const u32x2*)(rp + C_GLG); }
    bf16x8 sf[4][2], qf[4][4];
#pragma unroll
    for (int ks = 0; ks < 4; ++ks) {
        sf[ks][0] = *(const bf16x8*)(KVT + (size_t)(16 * (2 * w) + fr) * 128 + ks * 32 + fq * 8);
        sf[ks][1] = *(const bf16x8*)(KVT + (size_t)(16 * (2 * w + 1) + fr) * 128 + ks * 32 + fq * 8);
#pragma unroll
        for (int rt = 0; rt < 4; ++rt) qf[ks][rt] = *(const bf16x8*)(PR + (m0 + 16 * rt + fr) * NP + C_GLQ + h * 128 + ks * 32 + fq * 8);
    }
    f32x4 acc[4][2];
#pragma unroll
    for (int rt = 0; rt < 4; ++rt) { acc[rt][0] = (f32x4){0.f, 0.f, 0.f, 0.f}; acc[rt][1] = (f32x4){0.f, 0.f, 0.f, 0.f}; }
#pragma unroll
    for (int ks = 0; ks < 4; ++ks)
#pragma unroll
        for (int rt = 0; rt < 4; ++rt) { acc[rt][0] = MFMA16(sf[ks][0], qf[ks][rt], acc[rt][0]); acc[rt][1] = MFMA16(sf[ks][1], qf[ks][rt], acc[rt][1]); }
#pragma unroll
    for (int rt = 0; rt < 4; ++rt) { float ss = 0.f;
#pragma unroll
        for (int j = 0; j < 2; ++j) { acc[rt][j][0] += lo_f(oiv[rt][j].x); acc[rt][j][1] += hi_f(oiv[rt][j].x); acc[rt][j][2] += lo_f(oiv[rt][j].y); acc[rt][j][3] += hi_f(oiv[rt][j].y);
            ss += (acc[rt][j][0] * acc[rt][j][0] + acc[rt][j][1] * acc[rt][j][1]) + (acc[rt][j][2] * acc[rt][j][2] + acc[rt][j][3] * acc[rt][j][3]); }
        ss += __shfl_xor(ss, 16); ss += __shfl_xor(ss, 32);
        if (fq == 0) SS[(16 * rt + fr) * 8 + w] = ss; }
    __syncthreads();
#pragma unroll
    for (int rt = 0; rt < 4; ++rt) { const int r = 16 * rt + fr; const size_t m = m0 + r;
        const f32x4 sa = *(const LAS f32x4*)(SS + r * 8), sb = *(const LAS f32x4*)(SS + r * 8 + 4);
        const float tot = ((sa[0] + sa[1]) + (sa[2] + sa[3])) + ((sb[0] + sb[1]) + (sb[2] + sb[3]));
        const float rs = rsqrtf(tot * (1.f / 256.f) + EPS);
#pragma unroll
        for (int j = 0; j < 2; ++j) { const int dv = h * 256 + 16 * (2 * w + j) + 4 * fq; const f32x4 gn = ggv[j];
            u32x2 o; o.x = pk2(acc[rt][j][0] * rs * gn[0] * silu(lo_f(gv[rt][j].x)), acc[rt][j][1] * rs * gn[1] * silu(hi_f(gv[rt][j].x)));
            o.y = pk2(acc[rt][j][2] * rs * gn[2] * silu(lo_f(gv[rt][j].y)), acc[rt][j][3] * rs * gn[3] * silu(hi_f(gv[rt][j].y)));
            *(u32x2*)(MIX + m * DM + 1024 + dv) = o; } }
}

#define XB_TMO      128
#define XB_XCNT(j)  (256  + 64 * (j))
#define XB_XSUB(j)  (1280 + 64 * (j))
#define XB_XGEN(j)  (2304 + 64 * (j))
#define XB_TOP      3328
#define XB_TOPGEN   3392
#define XCD_BAR_WORDS 3456
#define XB_SPIN_CAP (1u << 18)
__device__ __forceinline__ unsigned xb_ld(unsigned* p)              { return __hip_atomic_load(p, __ATOMIC_RELAXED, __HIP_MEMORY_SCOPE_AGENT); }
__device__ __forceinline__ unsigned xb_add(unsigned* p, unsigned v) { return __hip_atomic_fetch_add(p, v, __ATOMIC_RELAXED, __HIP_MEMORY_SCOPE_AGENT); }
__device__ __forceinline__ unsigned xb_xcc_id() { return (unsigned)__builtin_amdgcn_s_getreg((3 << 11) | 20) & 0xFu; }
#define XB_SPIN(cond, bar) do { unsigned _sp = 0; while (cond) { __builtin_amdgcn_s_sleep(1); \
    if ((++_sp & 255u) == 0u) { if (xb_ld(&(bar)[XB_TMO])) break; if (_sp > XB_SPIN_CAP) { atomicAdd(&(bar)[XB_TMO], 1u); break; } } } } while (0)
struct XcdBarrier { unsigned* bar; unsigned x; volatile LAS unsigned* st; };
__device__ __forceinline__ XcdBarrier xcd_barrier_post(unsigned* bar, volatile LAS unsigned* st) {
    XcdBarrier b; b.bar = bar; b.x = xb_xcc_id(); b.st = st;
    if (threadIdx.x == 0) (void)xb_add(&bar[XB_XCNT(b.x)], 1u);
    return b;
}
__device__ __forceinline__ void xcd_barrier_complete(unsigned* bar, unsigned x, unsigned& nloc, unsigned& nx) {
    const unsigned G = gridDim.x * gridDim.y * gridDim.z;
    unsigned sum, cnt, mine, sp = 0u;
    for (;;) {
        sum = 0u; cnt = 0u; mine = 0u;
#pragma unroll
        for (unsigned j = 0; j < 16; ++j) { const unsigned c = xb_ld(&bar[XB_XCNT(j)]); sum += c; cnt += (c > 0u) ? 1u : 0u; mine = (j == x) ? c : mine; }
        if (sum == G) break;
        __builtin_amdgcn_s_sleep(1);
        if ((++sp & 255u) == 0u) { if (xb_ld(&bar[XB_TMO])) break; if (sp > XB_SPIN_CAP) { atomicAdd(&bar[XB_TMO], 1u); break; } }
    }
    nloc = mine > 0u ? mine : 1u; nx = cnt > 0u ? cnt : 1u;
}
__device__ __forceinline__ void xcd_barrier(const XcdBarrier& b) {
    asm volatile("s_waitcnt vmcnt(0)" ::: "memory");
    __syncthreads();
    if (threadIdx.x == 0) {
        unsigned* bar = b.bar;
        __builtin_amdgcn_s_waitcnt(0);
        unsigned nloc = b.st[0], nx = b.st[1];
        if (nloc == 0u) { xcd_barrier_complete(bar, b.x, nloc, nx); b.st[0] = nloc; b.st[1] = nx; }
        const unsigned old = xb_add(&bar[XB_XSUB(b.x)], 1u);
        const unsigned gen = old / nloc;
        if (old + 1u == (gen + 1u) * nloc) {
            __builtin_amdgcn_fence(__ATOMIC_RELEASE, "agent");
            asm volatile("s_waitcnt vmcnt(0)" ::: "memory");
            const unsigned og = xb_add(&bar[XB_TOP], 1u);
            const unsigned tg = og / nx;
            if (og + 1u == (tg + 1u) * nx) xb_add(&bar[XB_TOPGEN], 1u);
            else XB_SPIN(xb_ld(&bar[XB_TOPGEN]) == tg, bar);
            __builtin_amdgcn_fence(__ATOMIC_ACQUIRE, "agent");
            xb_add(&bar[XB_XGEN(b.x)], 1u);
            asm volatile("s_waitcnt vmcnt(0)" ::: "memory");
        } else {
            XB_SPIN(xb_ld(&bar[XB_XGEN(b.x)]) == gen, bar);
            __builtin_amdgcn_fence(__ATOMIC_ACQUIRE, "agent");
            asm volatile("s_waitcnt vmcnt(0)" ::: "memory");
        }
    }
    __syncthreads();
}

struct Args { const float* in[10]; float* out; unsigned char* ws; int ph_lo, ph_hi; };
constexpr int PH_PER_LAYER = 6, N_PHASES = DEPTH * PH_PER_LAYER;
constexpr size_t WS_CTL = 0, CTL_ZERO_BYTES = 65536;
constexpr int MISC_OFF = LDS_BYTES - 64;


__global__ void __launch_bounds__(NTHR, 2) hybrid_fwd(Args args) {
    extern __shared__ __attribute__((aligned(16))) unsigned char smem[];
    cg::grid_group grid = cg::this_grid();
    if (args.ph_lo < 0) grid.sync();
    {   LAS unsigned* m = (LAS unsigned*)(smem + MISC_OFF); if (threadIdx.x < 16) m[threadIdx.x] = 0u; __syncthreads(); }
    (void)xcd_barrier_post((unsigned*)(args.ws + WS_CTL), (volatile LAS unsigned*)((LAS unsigned char*)smem + MISC_OFF) + 8);
    for (int ph = args.ph_lo; ph < args.ph_hi; ++ph) {
        int tid = threadIdx.x, g = blockIdx.x, G = gridDim.x;
        asm volatile("" : "+v"(tid)); asm volatile("" : "+s"(g)); asm volatile("" : "+s"(G));
        LAS unsigned char* lds = (LAS unsigned char*)smem;
        Ptrs P; P.x = args.in[0]; P.norm_gain = args.in[1]; P.w_in = args.in[2]; P.qg = args.in[3]; P.kg = args.in[4]; P.og = args.in[5]; P.wa = args.in[6]; P.ba = args.in[7]; P.gg = args.in[8]; P.w_out = args.in[9];
        size_t oz0 = 0, oz1 = 0; asm volatile("" : "+s"(oz0)); asm volatile("" : "+s"(oz1));
        P.out = args.out + oz1; P.ws = args.ws + oz0;
        const int layer = ph / PH_PER_LAYER, k = ph % PH_PER_LAYER;
        const float* xin = layer == 0 ? P.x : P.out;
        if (k == 0) {
            if (layer == 0) phase_weights(P, lds, G, tid, g);
            phase_rownorm(P, xin, layer, G, tid, g);
        } else if (k == 1) {
            pg8::Gemm gm{(const bf16*)(P.ws + WS_XN), (const bf16*)(P.ws + WS_WIN + layer * WIN_L), M, NP, DM}; pg8::StaticOrder S; S.init(M, NP, G, g);
            pg8::EpiBf16 E{(bf16*)(P.ws + WS_PROJ), NP};
            pg8::gemm_phase<pg8::EpiBf16, pg8::StaticOrder, false, true>(lds, gm, S, E, tid);
        } else if (k == 2) {
            for (int c = g; c < 256; c += G) {
                const int bb = c >> 6, nn = c & 63;
                u32x4 bwv[4]; float biasv[4];
                {   const int lane_ = tid & 63, fr_ = lane_ & 15, fq_ = lane_ >> 4, c_ = 16 * (tid >> 6) + fr_;
#pragma unroll
                    for (int hh = 0; hh < 4; ++hh) { biasv[hh] = P.ba[layer * 512 + hh * 128 + c_]; bwv[hh] = (u32x4){0u, 0u, 0u, 0u};
                        if (fq_ < 2) { const float* wp = P.wa + (size_t)layer * 16 * 512 + (size_t)(8 * fq_) * 512 + hh * 128 + c_;
                            bwv[hh].x = pk2(wp[0], wp[512]); bwv[hh].y = pk2(wp[1024], wp[1536]); bwv[hh].z = pk2(wp[2048], wp[2560]); bwv[hh].w = pk2(wp[3072], wp[3584]); } } }
                gla_lowrank(P, lds, layer, (size_t)bb * SEQ + nn * 64, tid);
#pragma unroll
                for (int hh = 0; hh < 4; ++hh) gla_local_unit(P, lds, layer, ((bb * 4 + hh) << 6) + nn, tid, bwv[hh], biasv[hh]);
            }
            if (G == 256) attn_unit(P, lds, layer, (g & 7) * 32 + (g >> 3), tid);
            else for (int u = g; u < 256; u += G) attn_unit(P, lds, layer, u, tid);
        } else if (k == 3) {
            for (int gg = g; gg < 128; gg += G) gla_scan(P, lds, gg, tid);
            if (G == 256) {
                const int xb = 256 + (g & 7) * 64, li = g >> 3;
                if (li < 16) attn_unit(P, lds, layer, xb + li, tid);
                else for (int j = 0; j < 3; ++j) attn_unit(P, lds, layer, xb + 16 + (li - 16) * 3 + j, tid);
            } else for (int u = 256 + g; u < 768; u += G) attn_unit(P, lds, layer, u, tid);
        } else if (k == 4) {
            for (int u = g; u < 1024; u += G) gla_out_unit(P, lds, layer, u, tid);
            if (G == 256) attn_unit(P, lds, layer, 768 + (g & 7) * 32 + (g >> 3), tid);
            else for (int u = 768 + g; u < 1024; u += G) attn_unit(P, lds, layer, u, tid);
        } else {
            pg8::Gemm gm{(const bf16*)(P.ws + WS_MIX), (const bf16*)(P.ws + WS_WOUT + layer * WOUT_L), M, DM, DM}; pg8::StaticOrder S; S.init(M, DM, G, g);
            pg8::EpiRes E{xin, P.out, DM};
            pg8::gemm_phase<pg8::EpiRes, pg8::StaticOrder, true, true>(lds, gm, S, E, tid);
        }
        if (ph + 1 < args.ph_hi) { XcdBarrier b2; b2.bar = (unsigned*)(args.ws + WS_CTL); b2.x = xb_xcc_id(); b2.st = (volatile LAS unsigned*)((LAS unsigned char*)smem + MISC_OFF) + 8; xcd_barrier(b2); }
    }
}

extern "C" void kernel_launch(void* const* d_in, const int* in_sizes, int n_in, void* d_out, int out_size, void* d_ws, size_t ws_size, hipStream_t stream) {
    static int grid = 0;
    if (grid == 0) {
        if (n_in != 10 || out_size != M * DM || ws_size < WS_END) { fprintf(stderr, "kernel_launch: unexpected shapes (n_in %d out %d ws %zu)\n", n_in, out_size, ws_size); grid = -1; return; }
        int dev = 0, cus = 0, per_cu = 0;
        if (hipGetDevice(&dev) != hipSuccess || hipDeviceGetAttribute(&cus, hipDeviceAttributeMultiprocessorCount, dev) != hipSuccess) { grid = -1; return; }
        if (hipFuncSetAttribute((const void*)hybrid_fwd, hipFuncAttributeMaxDynamicSharedMemorySize, LDS_BYTES) != hipSuccess) { fprintf(stderr, "kernel_launch: hipFuncSetAttribute failed\n"); grid = -1; return; }
        if (hipOccupancyMaxActiveBlocksPerMultiprocessor(&per_cu, (const void*)hybrid_fwd, NTHR, LDS_BYTES) != hipSuccess || per_cu < 1) { fprintf(stderr, "kernel_launch: occupancy query says %d\n", per_cu); per_cu = 1; }
        (void)hipGetLastError();
        grid = cus;
    }
    if (grid < 0) return;
    if (hipMemsetAsync((char*)d_ws + WS_CTL, 0, CTL_ZERO_BYTES, stream) != hipSuccess) { fprintf(stderr, "kernel_launch: hipMemsetAsync failed\n"); return; }
    Args a{};
    for (int i = 0; i < 10; ++i) a.in[i] = (const float*)d_in[i];
    a.out = (float*)d_out; a.ws = (unsigned char*)d_ws; a.ph_lo = 0; a.ph_hi = N_PHASES;
#if MK_PER_PHASE
    for (int ph = 0; ph < N_PHASES; ++ph) { a.ph_lo = ph; a.ph_hi = ph + 1; hipLaunchKernelGGL(hybrid_fwd, dim3(grid), dim3(NTHR), LDS_BYTES, stream, a); }
#else
    void* kargs[] = {&a};
    hipError_t e = hipLaunchCooperativeKernel((const void*)hybrid_fwd, dim3(grid), dim3(NTHR), kargs, LDS_BYTES, stream);
    if (e != hipSuccess) fprintf(stderr, "cooperative launch failed: %s (grid %d)\n", hipGetErrorString(e), grid);
#endif
}
```
